# Optimizing an MI355X kernel written in HIP

```python
import jax, jax.numpy as jnp
from jax import lax
import numpy as np

D_MODEL = 2048
BATCH = 4
SEQ = 4096
DEPTH = 1

CHUNK = 64
MIX_WIDTH = D_MODEL
GMLP_WIN = 128
A_GROUP_DIM = 128
A_WIDTH = MIX_WIDTH // 2
A_GROUPS = A_WIDTH // A_GROUP_DIM
B_HEAD_DIM = 128
B_WIDTH = MIX_WIDTH - A_WIDTH
B_HEADS = B_WIDTH // B_HEAD_DIM
IDX_HEADS = 16
IDX_HEAD_DIM = 64
TOPK_MAX = 256
Q_BLOCK = 128
ROPE_THETA = 500000.0
B_ROT_DIM = B_HEAD_DIM // 4
IDX_ROT_DIM = IDX_HEAD_DIM // 4
D_FF = 5632
EPS = 1e-6
NEG = -1e30

COL_SIZES = (A_WIDTH, A_WIDTH,
             B_WIDTH, B_WIDTH, B_WIDTH,
             IDX_HEADS * IDX_HEAD_DIM,
             IDX_HEAD_DIM,
             IDX_HEADS)
N_IN_COLS = sum(COL_SIZES)
COL_SPLITS = tuple(int(v) for v in np.cumsum(COL_SIZES)[:-1])

kernel_name = "hybrid_gmlp_dsa_macaron_block"


def _rms(x, gain):
    xf = x.astype(jnp.float32)
    y = xf * lax.rsqrt(jnp.mean(xf * xf, axis=-1, keepdims=True) + EPS)
    return (y * gain.astype(jnp.float32)).astype(x.dtype)


def _layernorm(x, gain):
    xf = x.astype(jnp.float32)
    mu = jnp.mean(xf, axis=-1, keepdims=True)
    var = jnp.mean(jnp.square(xf - mu), axis=-1, keepdims=True)
    y = (xf - mu) * lax.rsqrt(var + EPS)
    return (y * gain.astype(jnp.float32)).astype(x.dtype)


def _modulate(h, shift, scale):
    return h * (1.0 + scale[:, None, :]) + shift[:, None, :]


def _rope_partial(x, positions, rot_dim):
    half = rot_dim // 2
    inv = ROPE_THETA ** (-2.0 * jnp.arange(half, dtype=jnp.float32) / rot_dim)
    ang = positions.astype(jnp.float32)[..., None] * inv
    cos = jnp.cos(ang)[:, :, None, :]
    sin = jnp.sin(ang)[:, :, None, :]
    xr = x[..., :rot_dim].astype(jnp.float32)
    x1, x2 = xr[..., :half], xr[..., half:]
    rot = jnp.concatenate([x1 * cos - x2 * sin, x2 * cos + x1 * sin], axis=-1)
    return jnp.concatenate([rot.astype(x.dtype), x[..., rot_dim:]], axis=-1)


def _swiglu(h, w1, w3, w2):
    return (jax.nn.silu(h @ w1) * (h @ w3)) @ w2


def _gmlp_mixer(u, v, v_gain, w_spatial, b_spatial):
    bsz, seq, _ = u.shape
    u = jax.nn.gelu(u)
    v = jax.nn.gelu(v)
    v = v.reshape(bsz, seq // GMLP_WIN, GMLP_WIN, A_GROUPS, A_GROUP_DIM)
    v = _layernorm(v, v_gain.reshape(A_GROUPS, A_GROUP_DIM))
    i = jnp.arange(GMLP_WIN)
    mask = (i[None, :] // CHUNK) <= (i[:, None] // CHUNK)
    w = jnp.where(mask[None], w_spatial, 0.0)
    mixed = jnp.einsum('gij,bnjgc->bnigc', w, v) + b_spatial.T[None, None, :, :, None]
    return u * mixed.reshape(bsz, seq, A_WIDTH)


def _dsa_mixer(q, k, v, q_idx, k_idx, w_idx, positions, q_norm_g, k_norm_g):
    bsz, seq, _ = q.shape
    q = q.reshape(bsz, seq, B_HEADS, B_HEAD_DIM)
    k = k.reshape(bsz, seq, B_HEADS, B_HEAD_DIM)
    v = v.reshape(bsz, seq, B_HEADS, B_HEAD_DIM)
    q = _rope_partial(_rms(q, q_norm_g), positions, B_ROT_DIM)
    k = _rope_partial(_rms(k, k_norm_g), positions, B_ROT_DIM)
    q_idx = _rope_partial(q_idx.reshape(bsz, seq, IDX_HEADS, IDX_HEAD_DIM), positions, IDX_ROT_DIM)
    k_idx = _rope_partial(k_idx[:, :, None, :], positions, IDX_ROT_DIM)[:, :, 0, :]
    k_idx32 = k_idx.astype(jnp.float32)

    topk = min(TOPK_MAX, seq // 4)
    nblk = seq // Q_BLOCK
    key_chunk = jnp.arange(seq) // CHUNK
    w_scale = (IDX_HEADS ** -0.5) * (IDX_HEAD_DIM ** -0.5)
    attn_scale = B_HEAD_DIM ** -0.5

    def to_blocks(a):
        return a.reshape(bsz, nblk, Q_BLOCK, *a.shape[2:]).swapaxes(0, 1)

    def gather_rows(kb, ib):
        return kb[ib]

    def one_block(args):
        start, qb, qib, wb = args
        q_chunk = (start + jnp.arange(Q_BLOCK)) // CHUNK
        admiss = key_chunk[None, :] <= q_chunk[:, None]
        logits = jnp.einsum('bqhd,bsd->bqhs', qib.astype(jnp.float32), k_idx32)
        iscore = jnp.einsum('bqh,bqhs->bqs', wb.astype(jnp.float32) * w_scale, jax.nn.relu(logits))
        iscore = jnp.where(admiss[None], iscore, NEG)
        _, sel = lax.top_k(iscore, topk)
        valid = key_chunk[sel] <= q_chunk[None, :, None]
        kg = jax.vmap(gather_rows)(k, sel)
        vg = jax.vmap(gather_rows)(v, sel)
        s = jnp.einsum('bqhd,bqkhd->bqhk', qb.astype(jnp.float32), kg.astype(jnp.float32)) * attn_scale
        s = jnp.where(valid[:, :, None, :], s, NEG)
        p = jax.nn.softmax(s, axis=-1)
        o = jnp.einsum('bqhk,bqkhd->bqhd', p, vg.astype(jnp.float32))
        return o.astype(qb.dtype)

    starts = jnp.arange(nblk) * Q_BLOCK
    out = lax.map(one_block, (starts, to_blocks(q), to_blocks(q_idx), to_blocks(w_idx)))
    return out.swapaxes(0, 1).reshape(bsz, seq, B_WIDTH)


def setup_inputs(seed: int = 0) -> dict:
    key = jax.random.key(seed)
    ks = jax.random.split(key, 24)
    f32 = jnp.float32

    def nrm(k, shape, fan_in):
        return jax.random.normal(k, shape, f32) * (fan_in ** -0.5)

    def gain(k, shape):
        return 1.0 + 0.01 * jax.random.normal(k, shape, f32)

    x = jax.random.normal(ks[0], (BATCH, SEQ, D_MODEL), f32)
    c = jax.random.normal(ks[1], (BATCH, D_MODEL), f32)
    start = jax.random.randint(ks[2], (BATCH, 1), 0, 1024, dtype=jnp.int32) * CHUNK
    positions = (start + jnp.arange(SEQ, dtype=jnp.int32)[None, :]).astype(jnp.int32)
    L = DEPTH
    return {
        "x": x,
        "c": c,
        "positions": positions,
        "w_ada": nrm(ks[3], (L, D_MODEL, 9 * D_MODEL), D_MODEL),
        "b_ada": 0.01 * jax.random.normal(ks[4], (L, 9 * D_MODEL), f32),
        "norm1_g": gain(ks[5], (L, D_MODEL)),
        "ffn1_w1": nrm(ks[6], (L, D_MODEL, D_FF), D_MODEL),
        "ffn1_w3": nrm(ks[7], (L, D_MODEL, D_FF), D_MODEL),
        "ffn1_w2": nrm(ks[8], (L, D_FF, D_MODEL), D_FF),
        "norm2_g": gain(ks[9], (L, D_MODEL)),
        "w_in": nrm(ks[10], (L, D_MODEL, N_IN_COLS), D_MODEL),
        "gmlp_v_g": gain(ks[11], (L, A_WIDTH)),
        "gmlp_ws": nrm(ks[12], (L, A_GROUPS, GMLP_WIN, GMLP_WIN), GMLP_WIN),
        "gmlp_b": gain(ks[13], (L, A_GROUPS, GMLP_WIN)),
        "q_norm_g": gain(ks[14], (L, B_HEAD_DIM)),
        "k_norm_g": gain(ks[15], (L, B_HEAD_DIM)),
        "out_norm_g": gain(ks[16], (L, MIX_WIDTH)),
        "w_out": nrm(ks[17], (L, MIX_WIDTH, D_MODEL), MIX_WIDTH),
        "norm3_g": gain(ks[18], (L, D_MODEL)),
        "ffn2_w1": nrm(ks[19], (L, D_MODEL, D_FF), D_MODEL),
        "ffn2_w3": nrm(ks[20], (L, D_MODEL, D_FF), D_MODEL),
        "ffn2_w2": nrm(ks[21], (L, D_FF, D_MODEL), D_FF),
    }


def reference(x, c, positions, w_ada, b_ada, norm1_g, ffn1_w1, ffn1_w3, ffn1_w2,
              norm2_g, w_in, gmlp_v_g, gmlp_ws, gmlp_b, q_norm_g, k_norm_g,
              out_norm_g, w_out, norm3_g, ffn2_w1, ffn2_w3, ffn2_w2):
    bsz, seq, _ = x.shape
    c_act = jax.nn.silu(c)
    for l in range(DEPTH):
        mod = c_act @ w_ada[l] + b_ada[l]
        sh1, sc1, g1, sh2, sc2, g2, sh3, sc3, g3 = jnp.split(mod, 9, axis=-1)

        h = _modulate(_rms(x, norm1_g[l]), sh1, sc1)
        x = x + 0.5 * g1[:, None, :] * _swiglu(h, ffn1_w1[l], ffn1_w3[l], ffn1_w2[l])

        h = _modulate(_rms(x, norm2_g[l]), sh2, sc2)
        proj = h @ w_in[l]
        a_u, a_v, b_q, b_k, b_v, i_q, i_k, i_w = jnp.split(proj, COL_SPLITS, axis=-1)
        out_a = _gmlp_mixer(a_u, a_v, gmlp_v_g[l], gmlp_ws[l], gmlp_b[l])
        out_b = _dsa_mixer(b_q, b_k, b_v, i_q, i_k, i_w, positions, q_norm_g[l], k_norm_g[l])
        groups = jnp.concatenate([
            out_a.reshape(bsz, seq, A_GROUPS, A_GROUP_DIM),
            out_b.reshape(bsz, seq, B_HEADS, B_HEAD_DIM)], axis=2)
        groups = _rms(groups, out_norm_g[l].reshape(A_GROUPS + B_HEADS, A_GROUP_DIM))
        mixed = groups.reshape(bsz, seq, MIX_WIDTH) @ w_out[l]
        x = x + g2[:, None, :] * mixed

        h = _modulate(_rms(x, norm3_g[l]), sh3, sc3)
        x = x + 0.5 * g3[:, None, :] * _swiglu(h, ffn2_w1[l], ffn2_w3[l], ffn2_w2[l])
    return x
```

```cpp
#include <hip/hip_runtime.h>
#include <hip/hip_cooperative_groups.h>
#include <cstdio>
#include <cstdint>
#include <cmath>
namespace cg = cooperative_groups;

#ifndef MK_SINGLE
#define MK_SINGLE 1
#endif

#define LAS __attribute__((address_space(3)))
typedef _Float16 h16;
typedef _Float16 h16x8 __attribute__((ext_vector_type(8)));
typedef _Float16 h16x4 __attribute__((ext_vector_type(4)));
typedef float f32x4 __attribute__((ext_vector_type(4)));
typedef __bf16 b16x8 __attribute__((ext_vector_type(8)));
typedef float f32x16 __attribute__((ext_vector_type(16)));

constexpr int NB = 4, SEQ = 4096, DM = 2048, NT = NB * SEQ, FF = 5632, NIN = 6224, NINP = 6400, NMOD = 9 * DM;
constexpr int NPH = 14;
constexpr int XCD_BAR_WORDS_C = 3456;
constexpr float EPS = 1e-6f;
constexpr int KSL = 32;

constexpr size_t SZ_W13 = (size_t)2 * FF * DM * 2, SZ_W2 = (size_t)DM * FF * 2;
constexpr size_t OFF_W13 = 0, OFF_W2 = OFF_W13 + SZ_W13;
constexpr size_t OFF_WIN = OFF_W2 + SZ_W2, OFF_WOUT = OFF_WIN + (size_t)NINP * DM * 2;
constexpr size_t OFF_ACT = OFF_WOUT + (size_t)DM * DM * 2;
constexpr size_t SC_PER_B = (size_t)4096 * 2080;
constexpr size_t OFF_SC = OFF_ACT, OFF_MASK = OFF_SC + SC_PER_B * 4 * NB, OFF_IQH = OFF_MASK + (size_t)NT * 64 * 8;
constexpr size_t OFF_IKH = OFF_IQH + (size_t)NT * 1024 * 2, OFF_IW = OFF_IKH + (size_t)NT * 64 * 2, END_OVL = OFF_IW + (size_t)NT * 16 * 4;
constexpr size_t OFF_H = OFF_ACT + (size_t)NT * FF * 2;
constexpr size_t OFF_P16 = OFF_H + (size_t)NT * DM * 2;
constexpr size_t OFF_I32 = OFF_P16 + (size_t)NT * 5120 * 2;
constexpr size_t OFF_PART = OFF_I32 + (size_t)NT * 1280 * 4;
constexpr size_t OFF_MOD = OFF_PART + (size_t)KSL * NB * NMOD * 4;
constexpr size_t OFF_CB = OFF_MOD + (size_t)NB * NMOD * 4, OFF_SB = OFF_CB + (size_t)NT * 16 * 4;
constexpr size_t OFF_CI = OFF_SB + (size_t)NT * 16 * 4, OFF_SI = OFF_CI + (size_t)NT * 8 * 4;
constexpr size_t OFF_BAR = OFF_SI + (size_t)NT * 8 * 4;
constexpr size_t WS_END = OFF_BAR + (size_t)XCD_BAR_WORDS_C * 4;
static_assert(END_OVL <= OFF_H, "overlay too large");
constexpr int LDS_BYTES = 131072 + 64;

struct Params {
    const float *x, *c; const int* pos;
    const float *w_ada, *b_ada, *n1g, *f1w1, *f1w3, *f1w2, *n2g, *w_in, *vg, *gws, *gb, *qg, *kg, *ong, *w_out, *n3g, *f2w1, *f2w3, *f2w2;
    float* out; unsigned char* ws;
    float invB[16]; float invI[8];
    int ph_lo, ph_hi;
};

template <int CTRL> __device__ __forceinline__ float dppf(float v) { return __builtin_bit_cast(float, __builtin_amdgcn_update_dpp(0, __builtin_bit_cast(int, v), CTRL, 0xF, 0xF, false)); }
__device__ __forceinline__ float red16(float v) {
    v += dppf<0x128>(v); v += dppf<0x124>(v); v += dppf<0x122>(v); v += dppf<0x121>(v);
    return v;
}
typedef unsigned u32x2_t __attribute__((ext_vector_type(2)));
__device__ __forceinline__ float xor32_sum(float v) { const unsigned b = __builtin_bit_cast(unsigned, v); const u32x2_t r = __builtin_amdgcn_permlane32_swap(b, b, false, false);
    return __builtin_bit_cast(float, r[0]) + __builtin_bit_cast(float, r[1]); }
__device__ __forceinline__ float xor32_max(float v) { const unsigned b = __builtin_bit_cast(unsigned, v); const u32x2_t r = __builtin_amdgcn_permlane32_swap(b, b, false, false);
    return fmaxf(__builtin_bit_cast(float, r[0]), __builtin_bit_cast(float, r[1])); }
__device__ __forceinline__ float wave_sum(float v) { v = red16(v); v += __shfl_xor(v, 16); v += __shfl_xor(v, 32); return v; }
__device__ __forceinline__ float gelu_t(float x) { const float u = 0.7978845608028654f * (x + 0.044715f * x * x * x); return x * __builtin_amdgcn_rcpf(1.f + __builtin_amdgcn_exp2f(-2.885390081777927f * u)); }
__device__ __forceinline__ float silu_f(float a) { return a * __builtin_amdgcn_rcpf(1.f + __builtin_amdgcn_exp2f(-1.4426950408889634f * a)); }
__device__ __forceinline__ int binof(unsigned u) {
    const unsigned bits = (u & 0x80000000u) ? (u ^ 0x80000000u) : ~u; const float s = __builtin_bit_cast(float, bits);
    return (int)fminf(fmaxf(s * 64.f + 1024.f, 0.f), 2047.f);
}
#define WAVE_LDS_SYNC() asm volatile("s_waitcnt lgkmcnt(0)" ::: "memory")

constexpr int BM = 256, BK = 64, HALF = 128, HTB = HALF * BK * 2, NXCD = 8;
__host__ __device__ __forceinline__ int lds_byte(int r, int c) { const int st = (r >> 4) * 2 + (c >> 5), rr = r & 15, cc = c & 31, ob = rr * 64 + cc * 2; return st * 1024 + (ob ^ (((ob >> 9) & 1) << 5)); }
__host__ __device__ __forceinline__ void stage_rc(int b, int& R, int& C) { const int st = b / 1024, sb = b % 1024, swz = sb ^ (((sb >> 9) & 1) << 5); R = (st >> 1) * 16 + swz / 64; C = (st & 1) * 32 + (swz % 64) / 2; }
__host__ __device__ __forceinline__ int perm32(int rho) { const int n = rho >> 4, i = rho & 15; return 8 * (i >> 2) + 4 * n + (i & 3); }
struct Unit { int pm, pn; };
template <int WGM> struct StaticOrder {
    int nM, nN, nwg, G, c;
    __device__ void init(int M, int N, int G_, int c_) { nM = M / BM; nN = N / BM; nwg = nM * nN; G = G_; c = c_; }
    __device__ bool next(int i, Unit& u) const {
        const long L = (long)i * G + c; if (L >= nwg) return false;
        int wgid = (int)L; { const int q = nwg / NXCD, r = nwg % NXCD, xcd = wgid % NXCD, off = wgid / NXCD; wgid = (xcd < r ? xcd * (q + 1) : r * (q + 1) + (xcd - r) * q) + off; }
        const int nig = WGM * nN, gid = wgid / nig, fm = gid * WGM, gsz = (nM - fm) < WGM ? (nM - fm) : WGM;
        u.pm = fm + ((wgid % nig) % gsz); u.pn = (wgid % nig) / gsz; return true;
    }
};

struct EpiSwiglu {
    static constexpr bool PERM = true;
    h16* O;
    __device__ __forceinline__ void operator()(const f32x4 (&acc)[2][2][4][2], const Unit& u, int wr, int wc, int fr, int fq) const {
        const int row0 = u.pm * BM + wr * 64 + fr, col0 = u.pn * 128 + wc * 32 + 8 * fq;
#pragma unroll
        for (int ai = 0; ai < 2; ++ai)
#pragma unroll
            for (int m = 0; m < 4; ++m) {
                h16* rowp = O + (size_t)(row0 + ai * HALF + m * 16) * FF + col0;
                h16x8 o;
#pragma unroll
                for (int n = 0; n < 2; ++n)
#pragma unroll
                    for (int j = 0; j < 4; ++j) o[n * 4 + j] = (h16)(silu_f(acc[ai][0][m][n][j]) * acc[ai][1][m][n][j]);
                *(h16x8*)rowp = o;
            }
    }
};
template <class RT, class OT> struct EpiResid {
    static constexpr bool PERM = true;
    const RT* res; OT* out; const float* gate; float coef;
    __device__ __forceinline__ void operator()(const f32x4 (&acc)[2][2][4][2], const Unit& u, int wr, int wc, int fr, int fq) const {
        const int row0 = u.pm * BM + wr * 64 + fr, col0 = u.pn * BM + wc * 32 + 8 * fq, b = u.pm >> 4;
        f32x4 gv[2][2];
#pragma unroll
        for (int bj = 0; bj < 2; ++bj)
#pragma unroll
            for (int n = 0; n < 2; ++n) gv[bj][n] = *(const f32x4*)(gate + (size_t)b * NMOD + col0 + bj * HALF + 4 * n) * coef;
#pragma unroll
        for (int ai = 0; ai < 2; ++ai)
#pragma unroll
            for (int m = 0; m < 4; ++m) {
                const size_t ro = (size_t)(row0 + ai * HALF + m * 16) * DM + col0;
#pragma unroll
                for (int bj = 0; bj < 2; ++bj) {
                    f32x4 r0, r1;
                    if constexpr (sizeof(RT) == 4) { r0 = *(const f32x4*)((const float*)res + ro + bj * HALF); r1 = *(const f32x4*)((const float*)res + ro + bj * HALF + 4); }
                    else { const h16x8 rr = *(const h16x8*)((const h16*)res + ro + bj * HALF);
#pragma unroll
                        for (int e2 = 0; e2 < 4; ++e2) { r0[e2] = (float)rr[e2]; r1[e2] = (float)rr[4 + e2]; } }
                    const f32x4 v0 = r0 + gv[bj][0] * acc[ai][bj][m][0], v1 = r1 + gv[bj][1] * acc[ai][bj][m][1];
                    if constexpr (sizeof(OT) == 4) { *(f32x4*)((float*)out + ro + bj * HALF) = v0; *(f32x4*)((float*)out + ro + bj * HALF + 4) = v1; }
                    else { h16x8 o;
#pragma unroll
                        for (int e2 = 0; e2 < 4; ++e2) { o[e2] = (h16)v0[e2]; o[4 + e2] = (h16)v1[e2]; }
                        *(h16x8*)((h16*)out + ro + bj * HALF) = o; }
                }
            }
    }
};
struct EpiNull { static constexpr bool PERM = true; float* sink;
    __device__ __forceinline__ void operator()(const f32x4 (&acc)[2][2][4][2], const Unit& u, int wr, int wc, int fr, int fq) const {
        float s = 0.f;
#pragma unroll
        for (int a = 0; a < 2; ++a)
#pragma unroll
            for (int b = 0; b < 2; ++b)
#pragma unroll
                for (int m = 0; m < 4; ++m)
#pragma unroll
                    for (int n = 0; n < 2; ++n) s += (acc[a][b][m][n][0] + acc[a][b][m][n][1]) + (acc[a][b][m][n][2] + acc[a][b][m][n][3]);
        if (s == 1.2345e30f) sink[0] = s; }
};
struct EpiProj {
    static constexpr bool PERM = false;
    h16* P16; h16* IQH; h16* IKH; float* IW; const float* COSI; const float* SINI; h16* VTG;
    __device__ __forceinline__ void operator()(const f32x4 (&acc)[2][2][4][2], const Unit& u, int wr, int wc, int fr, int fq) const {
        const int row0 = u.pm * BM + wr * 64 + fr;
        if (u.pn >= 16 && u.pn < 20) {
            const int b = u.pm >> 4, tokb = (u.pm & 15) * BM + wc * 32, p4 = 4 * ((fq & 1) * 2 + (fq >> 1));
#pragma unroll
            for (int ai = 0; ai < 2; ++ai)
#pragma unroll
                for (int m = 0; m < 4; ++m) {
                    const int head = (u.pn - 16) * 2 + ai, d = wr * 64 + m * 16 + fr;
                    h16* drow = VTG + (((size_t)b * 8 + head) * 128 + d) * SEQ + tokb + p4;
#pragma unroll
                    for (int bj = 0; bj < 2; ++bj)
#pragma unroll
                        for (int n = 0; n < 2; ++n) {
                            h16x4 o; const f32x4 v = acc[ai][bj][m][n];
                            o[0] = (h16)v[0]; o[1] = (h16)v[1]; o[2] = (h16)v[2]; o[3] = (h16)v[3];
                            *(h16x4*)(drow + bj * HALF + n * 16) = o;
                        }
                }
        } else if (u.pn < 20) {
            const int col0 = u.pn * BM + wc * 32 + 4 * fq; const bool act = u.pn < 4;
#pragma unroll
            for (int ai = 0; ai < 2; ++ai)
#pragma unroll
                for (int m = 0; m < 4; ++m) {
                    h16* rowp = P16 + (size_t)(row0 + ai * HALF + m * 16) * 5120 + col0;
#pragma unroll
                    for (int bj = 0; bj < 2; ++bj)
#pragma unroll
                        for (int n = 0; n < 2; ++n) {
                            h16x4 o; f32x4 v = acc[ai][bj][m][n];
                            if (act) {
#pragma unroll
                                for (int e = 0; e < 4; ++e) v[e] = gelu_t(v[e]);
                            }
                            o[0] = (h16)v[0]; o[1] = (h16)v[1]; o[2] = (h16)v[2]; o[3] = (h16)v[3];
                            *(h16x4*)(rowp + bj * HALF + n * 16) = o;
                        }
                }
        } else {
            const bool isk = u.pn == 24;
            const bool rot = isk ? (wc == 0) : ((wc & 1) == 0);
#pragma unroll
            for (int ai = 0; ai < 2; ++ai)
#pragma unroll
                for (int m = 0; m < 4; ++m) {
                    const size_t row = (size_t)(row0 + ai * HALF + m * 16);
                    f32x4 cs = (f32x4){1.f, 1.f, 1.f, 1.f}, sn = (f32x4){0.f, 0.f, 0.f, 0.f};
                    if (rot) { cs = *(const f32x4*)(COSI + row * 8 + 4 * (fq & 1)); sn = *(const f32x4*)(SINI + row * 8 + 4 * (fq & 1)); }
#pragma unroll
                    for (int bj = 0; bj < 2; ++bj) {
                        if (isk && bj == 1) continue;
#pragma unroll
                        for (int n = 0; n < 2; ++n) {
                            f32x4 v = acc[ai][bj][m][n];
                            if (n == 0 && rot) {
                                f32x4 pv;
#pragma unroll
                                for (int e = 0; e < 4; ++e) pv[e] = __shfl_xor(v[e], 32);
#pragma unroll
                                for (int e = 0; e < 4; ++e) v[e] = (fq < 2) ? v[e] * cs[e] - pv[e] * sn[e] : v[e] * cs[e] + pv[e] * sn[e];
                            }
                            if (!isk) {
                                h16x4 o; o[0] = (h16)v[0]; o[1] = (h16)v[1]; o[2] = (h16)v[2]; o[3] = (h16)v[3];
                                *(h16x4*)(IQH + row * 1024 + (u.pn - 20) * BM + bj * HALF + wc * 32 + n * 16 + 4 * fq) = o;
                            } else if (wc < 2) {
                                h16x4 o; o[0] = (h16)v[0]; o[1] = (h16)v[1]; o[2] = (h16)v[2]; o[3] = (h16)v[3];
                                *(h16x4*)(IKH + row * 64 + wc * 32 + n * 16 + 4 * fq) = o;
                            } else if (wc == 2 && n == 0) {
                                *(f32x4*)(IW + row * 16 + 4 * fq) = v * 0.03125f;
                            }
                        }
                    }
                }
        }
    }
};

template <int WGM, class Epi, bool SAME = false, int SKIP_PN = -1, bool BF16 = false, int SWAP_LO = -1, int SWAP_HI = -1>
__device__ __forceinline__ void gemm_phase(LAS unsigned char* lds, const h16* Ag, const h16* Btg, int M, int N, int K, const Epi& E) {
    const int tid = threadIdx.x, wid = __builtin_amdgcn_readfirstlane(tid >> 6), lane = tid & 63, wr = wid >> 2, wc = wid & 3, fr = lane & 15, fq = lane >> 4;
    const int nt = K / BK;
    StaticOrder<WGM> S; S.init(M, N, (int)gridDim.x, (int)blockIdx.x);
    unsigned voffA[2], voffB[2];
#pragma unroll
    for (int i = 0; i < 2; ++i) { int R, C; stage_rc(tid * 16 + i * 8192, R, C); const int Rb = Epi::PERM ? ((R & ~31) + perm32(R & 31)) : R;
        voffA[i] = (unsigned)(R * K + C) * 2u; voffB[i] = (unsigned)(Rb * K + C) * 2u; }
    const size_t kstep = (size_t)(BK * 2);
    const size_t hstep = (size_t)HALF * K * 2;
    const size_t tstep = 2 * hstep;
    const unsigned ldsw = (unsigned)wid * 1024u;
    const int aoff = lds_byte(wr * 64 + fr, fq * 8), boff = lds_byte(wc * 32 + fr, fq * 8);
#define PG8_SA(b, h) (((b) * 2 + (h)) * HTB)
#define PG8_SB(b, h) ((4 + (b) * 2 + (h)) * HTB)
#define PG8_STAGE(bufoff, gbase, voff) do { _Pragma("unroll") for (int _i = 0; _i < 2; ++_i) \
        __builtin_amdgcn_global_load_lds((const unsigned*)((const char*)(gbase) + (voff)[_i]), (LAS unsigned*)(lds + (bufoff) + ldsw + _i * 8192), 16, 0, 0); } while (0)
#define PG8_LDA(dst, b, h) do { _Pragma("unroll") for (int m = 0; m < 4; ++m) _Pragma("unroll") for (int k = 0; k < 2; ++k) dst[m][k] = *(const LAS h16x8*)(lds + PG8_SA(b, h) + aoff + m * 2048 + k * 1024); } while (0)
#define PG8_LDB(dst, b, h) do { _Pragma("unroll") for (int n = 0; n < 2; ++n) _Pragma("unroll") for (int k = 0; k < 2; ++k) dst[n][k] = *(const LAS h16x8*)(lds + PG8_SB(b, h) + boff + n * 2048 + k * 1024); } while (0)
#define PG8_MMA(ai, bj, At, Bt) do { __builtin_amdgcn_s_setprio(1); _Pragma("unroll") for (int m = 0; m < 4; ++m) _Pragma("unroll") for (int n = 0; n < 2; ++n) _Pragma("unroll") for (int k = 0; k < 2; ++k) \
        acc[ai][bj][m][n] = BF16 ? __builtin_amdgcn_mfma_f32_16x16x32_bf16(__builtin_bit_cast(b16x8, Bt[n][k]), __builtin_bit_cast(b16x8, At[m][k]), acc[ai][bj][m][n], 0, 0, 0) : __builtin_amdgcn_mfma_f32_16x16x32_f16(Bt[n][k], At[m][k], acc[ai][bj][m][n], 0, 0, 0); __builtin_amdgcn_s_setprio(0); } while (0)
#define PG8_WAIT_V(n) asm volatile("s_waitcnt vmcnt(" #n ")" ::: "memory")
#define PG8_WAIT_L(n) asm volatile("s_waitcnt lgkmcnt(" #n ")" ::: "memory")
#define PG8_BAR __builtin_amdgcn_s_barrier()
#define PG8_SCHED __builtin_amdgcn_sched_barrier(0)
    Unit cur, nxt; int ui = 0;
    if (!S.next(0, cur)) return;
    if (SAME) { cur.pm = 0; cur.pn = 0; }
    f32x4 acc[2][2][4][2];
#pragma unroll
    for (int a = 0; a < 2; ++a)
#pragma unroll
        for (int b = 0; b < 2; ++b)
#pragma unroll
            for (int m = 0; m < 4; ++m)
#pragma unroll
                for (int n = 0; n < 2; ++n) acc[a][b][m][n] = (f32x4){0.f, 0.f, 0.f, 0.f};
    h16x8 At[4][2], B0[2][2], B1[2][2];
#define PG8_SWP(u_) ((SWAP_LO >= 0) && (u_).pn >= SWAP_LO && (u_).pn < SWAP_HI)
    const char* cA = PG8_SWP(cur) ? (const char*)Btg + (size_t)cur.pn * tstep : (const char*)Ag + (size_t)cur.pm * tstep;
    const char* cB = PG8_SWP(cur) ? (const char*)Ag + (size_t)cur.pm * tstep : (const char*)Btg + (size_t)cur.pn * tstep;
    PG8_STAGE(PG8_SB(0, 0), cB, voffB); PG8_STAGE(PG8_SA(0, 0), cA, voffA); PG8_STAGE(PG8_SB(0, 1), cB + hstep, voffB); PG8_STAGE(PG8_SA(0, 1), cA + hstep, voffA);
    if (wr == 1) PG8_BAR;
    PG8_WAIT_V(4); PG8_BAR;
    PG8_STAGE(PG8_SB(1, 0), cB + kstep, voffB); PG8_STAGE(PG8_SA(1, 0), cA + kstep, voffA); PG8_STAGE(PG8_SB(1, 1), cB + hstep + kstep, voffB);
    PG8_WAIT_V(6); PG8_BAR;
    for (;;) {
        const bool has_next = S.next(ui + 1, nxt);
        if (SAME) { nxt.pm = 0; nxt.pn = 0; }
        const char* nA = has_next ? (PG8_SWP(nxt) ? (const char*)Btg + (size_t)nxt.pn * tstep : (const char*)Ag + (size_t)nxt.pm * tstep) : cA;
        const char* nB = has_next ? (PG8_SWP(nxt) ? (const char*)Ag + (size_t)nxt.pm * tstep : (const char*)Btg + (size_t)nxt.pn * tstep) : cB;
        const bool skipb1 = (SKIP_PN >= 0) && (cur.pn == SKIP_PN);
        for (int t = 0; t < nt; t += 2) {
            const bool last = (t == nt - 2);
            const char* a1 = cA + (size_t)(t + 1) * kstep;
            const char* a2 = last ? nA : cA + (size_t)(t + 2) * kstep; const char* b2 = last ? nB : cB + (size_t)(t + 2) * kstep;
            const char* a3 = a2 + kstep; const char* b3 = b2 + kstep;
            PG8_LDB(B0, 0, 0); PG8_SCHED; PG8_LDA(At, 0, 0); PG8_STAGE(PG8_SA(1, 1), a1 + hstep, voffA);
            PG8_WAIT_L(8); PG8_BAR; PG8_WAIT_L(0); PG8_MMA(0, 0, At, B0); PG8_BAR; PG8_SCHED;
            PG8_LDB(B1, 0, 1); PG8_STAGE(PG8_SB(0, 0), b2, voffB);
            PG8_BAR; PG8_WAIT_L(0); if (!skipb1) PG8_MMA(0, 1, At, B1); PG8_BAR;
            PG8_LDA(At, 0, 1); PG8_STAGE(PG8_SA(0, 0), a2, voffA);
            PG8_BAR; PG8_WAIT_L(0); PG8_MMA(1, 0, At, B0); PG8_BAR; PG8_SCHED;
            PG8_STAGE(PG8_SB(0, 1), b2 + hstep, voffB);
            PG8_WAIT_V(6); PG8_BAR; if (!skipb1) PG8_MMA(1, 1, At, B1); PG8_BAR;
            PG8_LDB(B0, 1, 0); PG8_SCHED; PG8_LDA(At, 1, 0); PG8_STAGE(PG8_SA(0, 1), a2 + hstep, voffA);
            PG8_WAIT_L(8); PG8_BAR; PG8_WAIT_L(0); PG8_MMA(0, 0, At, B0); PG8_BAR; PG8_SCHED;
            PG8_LDB(B1, 1, 1); PG8_STAGE(PG8_SB(1, 0), b3, voffB);
            PG8_BAR; PG8_WAIT_L(0); if (!skipb1) PG8_MMA(0, 1, At, B1); PG8_BAR;
            PG8_LDA(At, 1, 1); PG8_STAGE(PG8_SA(1, 0), a3, voffA);
            PG8_BAR; PG8_WAIT_L(0); PG8_MMA(1, 0, At, B0); PG8_BAR; PG8_SCHED;
            PG8_STAGE(PG8_SB(1, 1), b3 + hstep, voffB);
            PG8_WAIT_V(6); PG8_BAR; if (!skipb1) PG8_MMA(1, 1, At, B1); PG8_BAR;
        }
        E(acc, cur, wr, wc, fr, fq);
        if (!has_next) break;
#pragma unroll
        for (int a = 0; a < 2; ++a)
#pragma unroll
            for (int b = 0; b < 2; ++b)
#pragma unroll
                for (int m = 0; m < 4; ++m)
#pragma unroll
                    for (int n = 0; n < 2; ++n) acc[a][b][m][n] = (f32x4){0.f, 0.f, 0.f, 0.f};
        cur = nxt; cA = nA; cB = nB; ++ui;
    }
    PG8_WAIT_V(0);
    if (wr == 0) PG8_BAR;
    PG8_BAR;
#undef PG8_SWP
#undef PG8_SA
#undef PG8_SB
#undef PG8_STAGE
#undef PG8_LDA
#undef PG8_LDB
#undef PG8_MMA
#undef PG8_WAIT_V
#undef PG8_WAIT_L
#undef PG8_BAR
#undef PG8_SCHED
}

__device__ __forceinline__ void transpose_item(const float* W, int K, int N, int nvalid, h16* WT, int dst_row0, int k0, int n0, float* scr, int lane) {
    const int n4 = (lane & 7) * 4; const bool okn = n0 + n4 < nvalid;
    f32x4 tv[8];
#pragma unroll
    for (int i = 0; i < 8; ++i) { const int kk = 8 * i + (lane >> 3); tv[i] = okn ? *(const f32x4*)(W + (size_t)(k0 + kk) * N + n0 + n4) : (f32x4){0.f, 0.f, 0.f, 0.f}; }
#pragma unroll
    for (int i = 0; i < 8; ++i) { const int kk = 8 * i + (lane >> 3);
#pragma unroll
        for (int e = 0; e < 4; ++e) scr[kk * 33 + n4 + e] = tv[i][e]; }
    WAVE_LDS_SYNC();
    const int c = lane & 7;
#pragma unroll
    for (int j = 0; j < 4; ++j) { const int n = (lane >> 3) + 8 * j; const float* s = scr + (8 * c) * 33 + n;
        h16x8 o;
#pragma unroll
        for (int e = 0; e < 8; ++e) o[e] = (h16)s[e * 33];
        *(h16x8*)(WT + (size_t)(dst_row0 + n) * K + k0 + 8 * c) = o; }
    WAVE_LDS_SYNC();
}
__device__ __forceinline__ void convert_ffn(const float* w1, const float* w3, const float* w2, h16* W13, h16* W2, float* scr, int gw, int NGW, int lane) {
    constexpr int I13 = (DM / 64) * (FF / 32);
    constexpr int I2 = (FF / 64) * (DM / 32);
    for (int it = gw; it < 2 * I13 + I2; it += NGW) {
        if (it < 2 * I13) { const int hf = it >= I13, r = hf ? it - I13 : it; const int kb = r / (FF / 32), nb = r % (FF / 32), n0 = nb * 32;
            transpose_item(hf ? w3 : w1, DM, FF, FF, W13, (n0 >> 7) * 256 + hf * 128 + (n0 & 127), kb * 64, n0, scr, lane); }
        else { const int r = it - 2 * I13; const int kb = r / (DM / 32), nb = r % (DM / 32);
            transpose_item(w2, FF, DM, DM, W2, nb * 32, kb * 64, nb * 32, scr, lane); }
    }
}

template <class XT, class ModF>
__device__ __forceinline__ void norm_rows(const XT* X, const float* gain, int shift_i, int scale_i, h16* Hout, float* cA, float* cB, ModF modv, int rb) {
    const int tid = threadIdx.x, lane = tid & 63, wave = tid >> 6, b = rb >> 6;
    f32x4 nv[8];
#define NR_LOAD(row_) do { _Pragma("unroll") for (int j = 0; j < 8; ++j) { \
        if constexpr (sizeof(XT) == 4) nv[j] = ((const f32x4*)((const float*)X + (row_) * DM) + lane)[64 * j]; \
        else { const h16x4 hv_ = ((const h16x4*)((const h16*)X + (row_) * DM) + lane)[64 * j]; nv[j] = (f32x4){(float)hv_[0], (float)hv_[1], (float)hv_[2], (float)hv_[3]}; } } } while (0)
    NR_LOAD((size_t)rb * 64 + wave);
    for (int c = tid; c < DM; c += 512) { const float sc = modv(b, scale_i * DM + c), sh = modv(b, shift_i * DM + c); cA[c] = gain[c] * (1.f + sc); cB[c] = sh; }
    __syncthreads();
    for (int r = wave; r < 64; r += 8) {
        const size_t row = (size_t)rb * 64 + r;
        f32x4 v[8]; float ss = 0.f;
#pragma unroll
        for (int j = 0; j < 8; ++j) { v[j] = nv[j]; ss += (v[j][0] * v[j][0] + v[j][1] * v[j][1]) + (v[j][2] * v[j][2] + v[j][3] * v[j][3]); }
        if (r + 8 < 64) NR_LOAD(row + 8);
        const float rstd = rsqrtf(wave_sum(ss) * (1.f / DM) + EPS);
#pragma unroll
        for (int j = 0; j < 8; ++j) { const int c0 = 4 * lane + 256 * j; const f32x4 a = *(const f32x4*)(cA + c0), bb = *(const f32x4*)(cB + c0);
            h16x4 o;
#pragma unroll
            for (int e = 0; e < 4; ++e) o[e] = (h16)(v[j][e] * rstd * a[e] + bb[e]);
            *(h16x4*)(Hout + row * DM + c0) = o; }
    }
    __syncthreads();
#undef NR_LOAD
}


#define XB_TMO      128
#define XB_XCNT(j)  (256  + 64 * (j))
#define XB_XSUB(j)  (1280 + 64 * (j))
#define XB_XGEN(j)  (2304 + 64 * (j))
#define XB_TOP      3328
#define XB_TOPGEN   3392
#define XCD_BAR_WORDS 3456
#define XB_SPIN_CAP (1u << 18)
__device__ __forceinline__ unsigned xb_ld(unsigned* p)              { return __hip_atomic_load(p, __ATOMIC_RELAXED, __HIP_MEMORY_SCOPE_AGENT); }
__device__ __forceinline__ unsigned xb_add(unsigned* p, unsigned v) { return __hip_atomic_fetch_add(p, v, __ATOMIC_RELAXED, __HIP_MEMORY_SCOPE_AGENT); }
__device__ __forceinline__ unsigned xb_xcc_id() { return (unsigned)__builtin_amdgcn_s_getreg((3 << 11) | 20) & 0xFu; }
#define XB_SPIN(cond, bar) do { unsigned _sp = 0; while (cond) { __builtin_amdgcn_s_sleep(1); \
    if ((++_sp & 255u) == 0u) { if (xb_ld(&(bar)[XB_TMO])) break; if (_sp > XB_SPIN_CAP) { atomicAdd(&(bar)[XB_TMO], 1u); break; } } } } while (0)
struct XcdBarrier { unsigned* bar; unsigned x; volatile LAS unsigned* st; };
__device__ __forceinline__ XcdBarrier xcd_barrier_post(unsigned* bar, volatile LAS unsigned* st) {
    XcdBarrier b; b.bar = bar; b.x = xb_xcc_id(); b.st = st;
    if (threadIdx.x == 0) (void)xb_add(&bar[XB_XCNT(b.x)], 1u);
    return b;
}
__device__ __forceinline__ void xcd_barrier_complete(unsigned* bar, unsigned x, unsigned& nloc, unsigned& nx) {
    const unsigned G = gridDim.x * gridDim.y * gridDim.z;
    unsigned sum, cnt, mine, sp = 0u;
    for (;;) {
        sum = 0u; cnt = 0u; mine = 0u;
#pragma unroll
        for (unsigned j = 0; j < 16; ++j) { const unsigned c = xb_ld(&bar[XB_XCNT(j)]); sum += c; cnt += (c > 0u) ? 1u : 0u; mine = (j == x) ? c : mine; }
        if (sum == G) break;
        __builtin_amdgcn_s_sleep(1);
        if ((++sp & 255u) == 0u) { if (xb_ld(&bar[XB_TMO])) break; if (sp > XB_SPIN_CAP) { atomicAdd(&bar[XB_TMO], 1u); break; } }
    }
    nloc = mine > 0u ? mine : 1u; nx = cnt > 0u ? cnt : 1u;
}
__device__ __forceinline__ void xcd_barrier(const XcdBarrier& b) {
    asm volatile("s_waitcnt vmcnt(0)" ::: "memory");
    __syncthreads();
    if (threadIdx.x == 0) {
        unsigned* bar = b.bar;
        __builtin_amdgcn_s_waitcnt(0);
        unsigned nloc = b.st[0], nx = b.st[1];
        if (nloc == 0u) { xcd_barrier_complete(bar, b.x, nloc, nx); b.st[0] = nloc; b.st[1] = nx; }
        const unsigned old = xb_add(&bar[XB_XSUB(b.x)], 1u);
        const unsigned gen = old / nloc;
        if (old + 1u == (gen + 1u) * nloc) {
            __builtin_amdgcn_fence(__ATOMIC_RELEASE, "agent");
            asm volatile("s_waitcnt vmcnt(0)" ::: "memory");
            const unsigned og = xb_add(&bar[XB_TOP], 1u);
            const unsigned tg = og / nx;
            if (og + 1u == (tg + 1u) * nx) xb_add(&bar[XB_TOPGEN], 1u);
            else XB_SPIN(xb_ld(&bar[XB_TOPGEN]) == tg, bar);
            __builtin_amdgcn_fence(__ATOMIC_ACQUIRE, "agent");
            xb_add(&bar[XB_XGEN(b.x)], 1u);
            asm volatile("s_waitcnt vmcnt(0)" ::: "memory");
        } else {
            XB_SPIN(xb_ld(&bar[XB_XGEN(b.x)]) == gen, bar);
            __builtin_amdgcn_fence(__ATOMIC_ACQUIRE, "agent");
            asm volatile("s_waitcnt vmcnt(0)" ::: "memory");
        }
    }
    __syncthreads();
}

__global__ void __launch_bounds__(512, 2) mk_fwd(Params p) {
    extern __shared__ __attribute__((aligned(16))) unsigned char shm[];
    const int tid = threadIdx.x, lane = tid & 63, wave = tid >> 6;
    const int gw = blockIdx.x * 8 + wave, NGW = gridDim.x * 8;
    unsigned char* ws = p.ws;
    h16* W13 = (h16*)(ws + OFF_W13); h16* W2 = (h16*)(ws + OFF_W2); h16* WIN = (h16*)(ws + OFF_WIN); h16* WOUT = (h16*)(ws + OFF_WOUT);
    h16* ACT = (h16*)(ws + OFF_ACT); float* SC = (float*)(ws + OFF_SC); unsigned long long* MASK = (unsigned long long*)(ws + OFF_MASK);
    h16* IQH = (h16*)(ws + OFF_IQH); h16* IKH = (h16*)(ws + OFF_IKH); float* IW = (float*)(ws + OFF_IW);
    h16* H = (h16*)(ws + OFF_H); h16* P16 = (h16*)(ws + OFF_P16); float* I32 = (float*)(ws + OFF_I32);
    h16* X1H = (h16*)p.out;
    h16* X2H = (h16*)(ws + OFF_P16);
    h16* VTG = (h16*)(ws + OFF_I32);
    float* PART = (float*)(ws + OFF_PART); float* MOD = (float*)(ws + OFF_MOD);
    float* COSB = (float*)(ws + OFF_CB); float* SINB = (float*)(ws + OFF_SB); float* COSI = (float*)(ws + OFF_CI); float* SINI = (float*)(ws + OFF_SI);

    if (tid == 0) { ((volatile LAS unsigned*)(shm + 131072))[0] = 0u; ((volatile LAS unsigned*)(shm + 131072))[1] = 0u; }
    __syncthreads();
    XcdBarrier xbar; xbar.bar = (unsigned*)(ws + OFF_BAR); xbar.x = 0; xbar.st = (volatile LAS unsigned*)(shm + 131072);
    if (p.ph_hi - p.ph_lo > 1) xbar = xcd_barrier_post((unsigned*)(ws + OFF_BAR), (volatile LAS unsigned*)(shm + 131072));
#ifndef PH_MASK
#define PH_MASK 0xFFFF
#endif
#ifndef EXTRA_GEMM
#define EXTRA_GEMM 0
#endif
#ifndef REP_MASK
#define REP_MASK 0
#endif
#define PHASE(k) if (((PH_MASK >> (k)) & 1) && p.ph_lo <= (k) && (k) < p.ph_hi) _Pragma("nounroll") for (int rep_ = 0; rep_ <= ((REP_MASK >> (k)) & 1); ++rep_)
#define SEAM(k) if (p.ph_lo <= (k) && (k) + 1 < p.ph_hi) { if (p.ph_hi > 1000) cg::this_grid().sync(); else xcd_barrier(xbar); }

    PHASE(0) {
        float* scr = (float*)shm + wave * (64 * 33);
        convert_ffn(p.f1w1, p.f1w3, p.f1w2, W13, W2, scr, gw, NGW, lane);
        {   constexpr int IIN = (DM / 64) * (NINP / 32), IOUT = (DM / 64) * (DM / 32);
            for (int it = gw; it < IIN + IOUT; it += NGW) {
                if (it < IIN) { const int kb = it / (NINP / 32), nb = it % (NINP / 32); transpose_item(p.w_in, DM, NIN, NIN, WIN, nb * 32, kb * 64, nb * 32, scr, lane); }
                else { const int r = it - IIN; const int kb = r / (DM / 32), nb = r % (DM / 32); transpose_item(p.w_out, DM, DM, DM, WOUT, nb * 32, kb * 64, nb * 32, scr, lane); }
            } }
        for (int task = gw; task < 72 * KSL; task += NGW) {
            const int cgp = task % 72, ks = task / 72, col = cgp * 256 + lane * 4, k0 = ks * 64;
            float cv[4];
#pragma unroll
            for (int b = 0; b < 4; ++b) cv[b] = silu_f(p.c[b * DM + k0 + lane]);
            f32x4 a[4];
#pragma unroll
            for (int b = 0; b < 4; ++b) a[b] = (f32x4){0.f, 0.f, 0.f, 0.f};
#pragma unroll 8
            for (int r = 0; r < 64; ++r) {
                const f32x4 w = *(const f32x4*)(p.w_ada + (size_t)(k0 + r) * NMOD + col);
#pragma unroll
                for (int b = 0; b < 4; ++b) { const float s = __builtin_bit_cast(float, __builtin_amdgcn_readlane(__builtin_bit_cast(int, cv[b]), r)); a[b] += s * w; }
            }
#pragma unroll
            for (int b = 0; b < 4; ++b) *(f32x4*)(PART + ((size_t)ks * 4 + b) * NMOD + col) = a[b];
        }
        for (int t = blockIdx.x * 512 + tid; t < NT * 24; t += gridDim.x * 512) {
            const int tok = t / 24, i = t % 24;
            const float inv = i < 16 ? p.invB[i] : p.invI[i - 16];
            const float ang = (float)p.pos[tok] * inv;
            const double a = (double)ang, kq = rint(a * 0.6366197723675814);
            double r = fma(-kq, 1.5707963267948966, a); r = fma(-kq, 6.123233995736766e-17, r);
            const int q = ((int)kq) & 3; const double r2 = r * r;
            const double sn = r * (1.0 + r2 * (-1.0 / 6 + r2 * (1.0 / 120 + r2 * (-1.0 / 5040 + r2 * (1.0 / 362880 + r2 * (-1.0 / 39916800 + r2 * (1.0 / 6227020800.0)))))));
            const double cs = 1.0 + r2 * (-0.5 + r2 * (1.0 / 24 + r2 * (-1.0 / 720 + r2 * (1.0 / 40320 + r2 * (-1.0 / 3628800 + r2 * (1.0 / 479001600.0 - r2 * (1.0 / 87178291200.0)))))));
            const double sq = (q == 0) ? sn : (q == 1) ? cs : (q == 2) ? -sn : -cs;
            const double cq = (q == 0) ? cs : (q == 1) ? -sn : (q == 2) ? -cs : sn;
            if (i < 16) { COSB[tok * 16 + i] = (float)cq; SINB[tok * 16 + i] = (float)sq; } else { COSI[tok * 8 + i - 16] = (float)cq; SINI[tok * 8 + i - 16] = (float)sq; }
        }
    }
    SEAM(0)
    PHASE(1) {
        for (int i = blockIdx.x * 512 + tid; i < NB * NMOD; i += gridDim.x * 512) {
            const int b = i / NMOD, n = i % NMOD; float s = p.b_ada[n];
            for (int k = 0; k < KSL; ++k) s += PART[((size_t)k * 4 + b) * NMOD + n];
            MOD[i] = s;
        }
        float* cA = (float*)shm; float* cB = cA + DM;
        const float* bada = p.b_ada;
        auto modv = [PART, bada](int b, int n) { float s = bada[n]; for (int k = 0; k < KSL; ++k) s += PART[((size_t)k * 4 + b) * NMOD + n]; return s; };
        for (int rbi = blockIdx.x; rbi < NT / 64; rbi += gridDim.x) { const int rb = (rbi & 7) * 32 + (rbi >> 3); norm_rows(p.x, p.n1g, 0, 1, H, cA, cB, modv, rb); }
    }
    SEAM(1)
    PHASE(2) { EpiSwiglu E{ACT}; gemm_phase<4>((LAS unsigned char*)shm, H, W13, NT, 2 * FF, DM, E); }
#if EXTRA_GEMM == 2
    { EpiSwiglu E{ACT}; gemm_phase<4>((LAS unsigned char*)shm, H, W13, NT, 2 * FF, DM, E); }
#endif
#if EXTRA_GEMM == 40
    { EpiNull E{MOD}; gemm_phase<8, EpiNull, false, -1, false>((LAS unsigned char*)shm, H, W13, NT, 2 * FF, DM, E); }
#endif
#if EXTRA_GEMM == 41
    { EpiNull E{MOD}; gemm_phase<8, EpiNull, false, -1, true>((LAS unsigned char*)shm, H, W13, NT, 2 * FF, DM, E); }
#endif
#if EXTRA_GEMM == 22
    { EpiSwiglu E{ACT}; gemm_phase<8, EpiSwiglu, true>((LAS unsigned char*)shm, H, W13, NT, 2 * FF, DM, E); }
#endif
    SEAM(2)
    PHASE(3) { EpiResid<float, h16> E{p.x, X1H, MOD + 2 * DM, 0.5f}; gemm_phase<4>((LAS unsigned char*)shm, ACT, W2, NT, DM, FF, E); }
#if EXTRA_GEMM == 33
    { EpiResid<float, h16> E{p.x, X1H, MOD + 2 * DM, 0.5f}; gemm_phase<4, EpiResid<float, h16>, true>((LAS unsigned char*)shm, ACT, W2, NT, DM, FF, E); }
#endif
#if EXTRA_GEMM == 3
    { EpiResid<float, h16> E{p.x, X1H, MOD + 2 * DM, 0.5f}; gemm_phase<4>((LAS unsigned char*)shm, ACT, W2, NT, DM, FF, E); }
#endif
    SEAM(3)
    PHASE(4) {
        float* cA = (float*)shm; float* cB = cA + DM;
        auto modv = [MOD](int b, int n) { return MOD[(size_t)b * NMOD + n]; };
        for (int rbi = blockIdx.x; rbi < NT / 64; rbi += gridDim.x) { const int rb = (rbi & 7) * 32 + (rbi >> 3); norm_rows(X1H, p.n2g, 3, 4, H, cA, cB, modv, rb); }
    }
    SEAM(4)
    PHASE(5) { EpiProj E{P16, IQH, IKH, IW, COSI, SINI, VTG}; gemm_phase<4, EpiProj, false, 24, false, 16, 20>((LAS unsigned char*)shm, H, WIN, NT, NINP, DM, E);
        const int nextra = (64 * (NINP / 256)) % (int)gridDim.x;
        if ((int)blockIdx.x >= nextra) { float* scr = (float*)shm + wave * (64 * 33);
            convert_ffn(p.f2w1, p.f2w3, p.f2w2, W13, W2, scr, ((int)blockIdx.x - nextra) * 8 + wave, ((int)gridDim.x - nextra) * 8, lane); }
    }
#if EXTRA_GEMM == 5
    { EpiProj E{P16, IQH, IKH, IW, COSI, SINI}; gemm_phase<8>((LAS unsigned char*)shm, H, WIN, NT, NINP, DM, E); }
#endif
    SEAM(5)
    PHASE(6) {
        const int li = lane & 15;
#define P6_ROW(i_) (((((i_) >> 3) & 7) << 11) | ((i_) & 7) | ((((i_) >> 6) & 31) << 3) | (((i_) >> 11) << 8))
        h16x8 nvin[4];
        if (gw < NT) {
#pragma unroll
            for (int ch = 4; ch < 8; ++ch) nvin[ch - 4] = *(const h16x8*)(P16 + (size_t)P6_ROW(gw) * 5120 + ch * 512 + lane * 8); }
        for (int ri = gw; ri < NT; ri += NGW) {
            const int row = P6_ROW(ri);
            h16* pr = P16 + (size_t)row * 5120;
            const float* cb = COSB + (size_t)row * 16; const float* sb = SINB + (size_t)row * 16;
            h16x8 vin[8];
#pragma unroll
            for (int ch = 4; ch < 8; ++ch) vin[ch] = nvin[ch - 4];
            if (ri + NGW < NT) {
#pragma unroll
                for (int ch = 4; ch < 8; ++ch) nvin[ch - 4] = *(const h16x8*)(P16 + (size_t)P6_ROW(ri + NGW) * 5120 + ch * 512 + lane * 8); }
#pragma unroll
            for (int ch = 4; ch < 8; ++ch) {
                h16x8 v = vin[ch];
                float f[8];
#pragma unroll
                for (int e = 0; e < 8; ++e) f[e] = (float)v[e];
                if (ch < 2) {
#pragma unroll
                    for (int e = 0; e < 8; ++e) f[e] = gelu_t(f[e]);
                } else if (ch < 4) {
                    float s = 0.f;
#pragma unroll
                    for (int e = 0; e < 8; ++e) { f[e] = gelu_t(f[e]); s += f[e]; }
                    const float mu = red16(s) * (1.f / 128.f); float ss = 0.f;
#pragma unroll
                    for (int e = 0; e < 8; ++e) { f[e] -= mu; ss += f[e] * f[e]; }
                    const float rstd = rsqrtf(red16(ss) * (1.f / 128.f) + EPS);
                    const float* g = p.vg + (ch - 2) * 512 + lane * 8;
#pragma unroll
                    for (int e = 0; e < 8; ++e) f[e] = f[e] * rstd * g[e];
                } else {
                    float ss = 0.f;
#pragma unroll
                    for (int e = 0; e < 8; ++e) ss += f[e] * f[e];
                    const float rstd = rsqrtf(red16(ss) * (1.f / 128.f) + EPS);
                    const float* g = (ch < 6 ? p.qg : p.kg) + li * 8;
                    float py[8];
#pragma unroll
                    for (int e = 0; e < 8; ++e) { f[e] = f[e] * rstd * g[e]; py[e] = __shfl_xor(f[e], 2); }
                    if (li < 4) {
#pragma unroll
                        for (int e = 0; e < 8; ++e) { const int fi = (li & 1) * 8 + e; const float cs = cb[fi], sn = sb[fi];
                            f[e] = (li < 2) ? f[e] * cs - py[e] * sn : f[e] * cs + py[e] * sn; }
                    }
                    if (ch < 6) {
#pragma unroll
                        for (int e = 0; e < 8; ++e) f[e] *= 0.12751743f;
                    }
                }
#pragma unroll
                for (int e = 0; e < 8; ++e) v[e] = (h16)f[e];
                *(h16x8*)(pr + ch * 512 + lane * 8) = v;
            }
        }
    }
    PHASE(7) {
        {
            h16* VT = (h16*)shm;
            const int fr = lane & 15, fq = lane >> 4;
            h16x8 nvn[4];
#define GM_LOAD(u_) do { const int g_ = (u_) & 7, win_ = ((u_) >> 3) & 31, b_ = (u_) >> 8; _Pragma("unroll") for (int i = 0; i < 4; ++i) { const int pc = tid + 512 * i; \
                nvn[i] = *(const h16x8*)(P16 + ((size_t)b_ * SEQ + win_ * 128 + (pc >> 4)) * 5120 + 1024 + g_ * 128 + (pc & 15) * 8); } } while (0)
            if ((int)blockIdx.x < NB * 32 * 8) GM_LOAD((int)blockIdx.x);
            for (int u = blockIdx.x; u < NB * 32 * 8; u += gridDim.x) {
                const int g = u & 7, win = (u >> 3) & 31, b = u >> 8;
                const size_t tok0 = (size_t)b * SEQ + win * 128;
                const int irow = 16 * wave + fr;
                const size_t tok = tok0 + irow;
                h16x8 cvn[4];
#pragma unroll
                for (int i = 0; i < 4; ++i) cvn[i] = nvn[i];
                f32x4 w0[4], w1[4]; h16x4 uu[8];
#pragma unroll
                for (int ks = 0; ks < 4; ++ks) { const float* wp = p.gws + ((size_t)g * 128 + irow) * 128 + 32 * ks + 8 * fq; w0[ks] = *(const f32x4*)wp; w1[ks] = *(const f32x4*)(wp + 4); }
#pragma unroll
                for (int nt = 0; nt < 8; ++nt) uu[nt] = *(const h16x4*)(P16 + tok * 5120 + g * 128 + 16 * nt + 4 * fq);
                const float bias = p.gb[g * 128 + irow];
                if (u + (int)gridDim.x < NB * 32 * 8) GM_LOAD(u + (int)gridDim.x);
                __syncthreads();
#pragma unroll
                for (int i = 0; i < 4; ++i) { const int pc = tid + 512 * i, j = pc >> 4, c8 = pc & 15;
                    float f[8]; float s1 = 0.f;
#pragma unroll
                    for (int e = 0; e < 8; ++e) { f[e] = gelu_t((float)cvn[i][e]); s1 += f[e]; }
                    const float mu = red16(s1) * (1.f / 128.f); float s2 = 0.f;
#pragma unroll
                    for (int e = 0; e < 8; ++e) { f[e] -= mu; s2 += f[e] * f[e]; }
                    const float rs = rsqrtf(red16(s2) * (1.f / 128.f) + EPS);
                    const float* gp = p.vg + g * 128 + c8 * 8;
#pragma unroll
                    for (int e = 0; e < 8; ++e) VT[(c8 * 8 + e) * 136 + ((((j >> 3) ^ c8) & 15) << 3) + (j & 7)] = (h16)(f[e] * rs * gp[e]); }
                __syncthreads();
                h16x8 wf[4];
#pragma unroll
                for (int ks = 0; ks < 4; ++ks) { const int j0 = 32 * ks + 8 * fq; const bool ok = (j0 >> 6) <= (irow >> 6);
#pragma unroll
                    for (int e = 0; e < 4; ++e) { wf[ks][e] = ok ? (h16)w0[ks][e] : (h16)0.f; wf[ks][4 + e] = ok ? (h16)w1[ks][e] : (h16)0.f; } }
                f32x4 acc[8];
#pragma unroll
                for (int nt = 0; nt < 8; ++nt) { acc[nt] = (f32x4){0.f, 0.f, 0.f, 0.f};
#pragma unroll
                    for (int ks = 0; ks < 4; ++ks) { const h16x8 vf = *(const h16x8*)(VT + (16 * nt + fr) * 136 + ((((4 * ks + fq) ^ ((16 * nt + fr) >> 3)) & 15) << 3));
                        acc[nt] = __builtin_amdgcn_mfma_f32_16x16x32_f16(vf, wf[ks], acc[nt], 0, 0, 0); } }
                float ss = 0.f;
#pragma unroll
                for (int nt = 0; nt < 8; ++nt) {
#pragma unroll
                    for (int e = 0; e < 4; ++e) { const float o = (float)uu[nt][e] * (acc[nt][e] + bias); acc[nt][e] = o; ss += o * o; } }
                ss += __shfl_xor(ss, 16); ss += __shfl_xor(ss, 32);
                const float rstd = rsqrtf(ss * (1.f / 128.f) + EPS);
#pragma unroll
                for (int nt = 0; nt < 8; ++nt) { const f32x4 gg = *(const f32x4*)(p.ong + g * 128 + 16 * nt + 4 * fq); h16x4 o;
#pragma unroll
                    for (int e = 0; e < 4; ++e) o[e] = (h16)(acc[nt][e] * rstd * gg[e]);
                    *(h16x4*)(H + tok * DM + g * 128 + 16 * nt + 4 * fq) = o; }
            }
            __syncthreads();
        }
        {
            h16* IQS = (h16*)shm;
            float* WS = (float*)(shm + 32 * 1032 * 2);
            const int fr = lane & 15, fq = lane >> 4;
            for (int pi = blockIdx.x; pi < 256; pi += gridDim.x) {
                const int b = pi >> 6, r = pi & 63;
#pragma unroll 1
                for (int half = 0; half < 2; ++half) {
                    const int c32 = half ? 127 - r : r, chunk = c32 >> 1, nkt = chunk + 1, N = 64 * nkt;
                    const size_t tok0 = (size_t)b * SEQ + c32 * 32;
                    __syncthreads();
#pragma unroll
                    for (int i = 0; i < 8; ++i) { const int pc = tid + 512 * i, q = pc >> 7, c8 = pc & 127;
                        *(h16x8*)(IQS + q * 1032 + c8 * 8) = *(const h16x8*)(IQH + (tok0 + q) * 1024 + c8 * 8); }
                    WS[tid] = IW[tok0 * 16 + tid];
                    __syncthreads();
                    float* scb = SC + (size_t)b * SC_PER_B + (size_t)4096 * (chunk * (chunk + 1) / 2) + (size_t)((c32 & 1) * 32) * N;
                    h16x8 kfn[4][2];
#define IK_LOAD(kt_) do { _Pragma("unroll") for (int kk = 0; kk < 4; ++kk) _Pragma("unroll") for (int ks = 0; ks < 2; ++ks) \
                        kfn[kk][ks] = *(const h16x8*)(IKH + ((size_t)b * SEQ + 64 * (kt_) + 16 * kk + fr) * 64 + 32 * ks + 8 * fq); } while (0)
                    if (wave < nkt) IK_LOAD(wave);
                    for (int kt = wave; kt < nkt; kt += 8) {
                        h16x8 kf[4][2];
#pragma unroll
                        for (int kk = 0; kk < 4; ++kk)
#pragma unroll
                            for (int ks = 0; ks < 2; ++ks) kf[kk][ks] = kfn[kk][ks];
                        if (kt + 8 < nkt) IK_LOAD(kt + 8);
                        f32x4 s[2][4];
#pragma unroll
                        for (int qt = 0; qt < 2; ++qt)
#pragma unroll
                            for (int kk = 0; kk < 4; ++kk) s[qt][kk] = (f32x4){0.f, 0.f, 0.f, 0.f};
#pragma unroll 2
                        for (int h = 0; h < 16; ++h) {
#pragma unroll
                            for (int qt = 0; qt < 2; ++qt) {
                                const h16x8 q0 = *(const h16x8*)(IQS + (16 * qt + fr) * 1032 + h * 64 + 8 * fq);
                                const h16x8 q1 = *(const h16x8*)(IQS + (16 * qt + fr) * 1032 + h * 64 + 32 + 8 * fq);
                                const float wv = WS[(16 * qt + fr) * 16 + h];
#pragma unroll
                                for (int kk = 0; kk < 4; ++kk) {
                                    f32x4 t = (f32x4){0.f, 0.f, 0.f, 0.f};
                                    t = __builtin_amdgcn_mfma_f32_16x16x32_f16(kf[kk][0], q0, t, 0, 0, 0);
                                    t = __builtin_amdgcn_mfma_f32_16x16x32_f16(kf[kk][1], q1, t, 0, 0, 0);
#pragma unroll
                                    for (int e = 0; e < 4; ++e) s[qt][kk][e] += wv * fmaxf(t[e], 0.f);
                                }
                            }
                        }
#pragma unroll
                        for (int qt = 0; qt < 2; ++qt)
#pragma unroll
                            for (int kk = 0; kk < 4; ++kk) *(f32x4*)(scb + (size_t)(16 * qt + fr) * N + 64 * kt + 16 * kk + 4 * fq) = s[qt][kk];
                    }
                }
            }
            __syncthreads();
        }
    }
    SEAM(7)
    PHASE(8) {
        unsigned* hist = (unsigned*)(shm + wave * 9216);
        unsigned* cand = (unsigned*)(shm + wave * 9216 + 8192);
        unsigned raw[64];
#define P8_LOAD(idx_) do { const int b_ = (idx_) >> 12, j_ = (idx_) & 4095, q_ = j_ < 2048 ? j_ : 6143 - j_, ch_ = q_ >> 6, nm_ = ch_ + 1; \
            const float* sp_ = SC + (size_t)b_ * SC_PER_B + (size_t)4096 * (ch_ * (ch_ + 1) / 2) + (size_t)(q_ & 63) * (64 * nm_) + lane; \
            _Pragma("unroll") for (int m = 0; m < 64; ++m) raw[m] = (m < nm_) ? __builtin_bit_cast(unsigned, sp_[64 * m]) : 0xFFFFFFFFu; } while (0)
        if (gw < NT) P8_LOAD(gw);
        for (int idx = gw; idx < NT; idx += NGW) {
            const int b = idx >> 12, jj = idx & 4095, q = jj < 2048 ? jj : 6143 - jj, row = b * 4096 + q;
            const int chunk = q >> 6, nm = chunk + 1;
            unsigned u[64];
#pragma unroll
            for (int m = 0; m < 64; ++m) { const unsigned bits = raw[m]; u[m] = (bits & 0x80000000u) ? ~bits : (bits | 0x80000000u); }
            if (idx + NGW < NT) P8_LOAD(idx + NGW);
            unsigned T = 0u;
            if (nm > 4) {
#pragma unroll
                for (int i = 0; i < 8; ++i) ((uint4*)hist)[lane + 64 * i] = make_uint4(0u, 0u, 0u, 0u);
                WAVE_LDS_SYNC();
                unsigned bpk[32];
#pragma unroll
                for (int m8 = 0; m8 < 8; ++m8) {
                    if (m8 * 8 < nm) {
#pragma unroll
                        for (int e = 0; e < 8; e += 2) { const int b0 = binof(u[m8 * 8 + e]), b1 = binof(u[m8 * 8 + e + 1]);
                            atomicAdd(&hist[b0], 1u); atomicAdd(&hist[b1], 1u); bpk[m8 * 4 + (e >> 1)] = (unsigned)b0 | ((unsigned)b1 << 16); }
                    } else {
#pragma unroll
                        for (int e = 0; e < 4; ++e) bpk[m8 * 4 + e] = 0u;
                    }
                }
                WAVE_LDS_SYNC();
                uint4 hv[8]; unsigned tl = 0u;
#pragma unroll
                for (int i = 0; i < 8; ++i) { hv[i] = ((const uint4*)hist)[lane * 8 + i]; tl += (hv[i].x + hv[i].y) + (hv[i].z + hv[i].w); }
                unsigned S = tl;
#pragma unroll
                for (int o = 1; o < 64; o <<= 1) { const unsigned t = __shfl_down(S, o); if (lane + o < 64) S += t; }
                const unsigned above = S - tl;
                const bool owner = (above < 256u) && (S >= 256u);
                unsigned c = above, Bv = 0u, cv = 0u; bool found = false;
#pragma unroll
                for (int i = 7; i >= 0; --i) {
                    const unsigned hh[4] = {hv[i].x, hv[i].y, hv[i].z, hv[i].w};
#pragma unroll
                    for (int e = 3; e >= 0; --e) { if (!found && c + hh[e] >= 256u) { found = true; Bv = 32u * lane + 4u * i + e; cv = c; } c += hh[e]; }
                }
                const unsigned long long om = __ballot(owner);
                const int ol = om ? __ffsll((long long)om) - 1 : 0;
                const int B = __builtin_amdgcn_readlane((int)Bv, ol), chi = __builtin_amdgcn_readlane((int)cv, ol);
                const int r = 256 - chi;
                int M = 0;
#pragma unroll
                for (int m8 = 0; m8 < 8; ++m8) if (m8 * 8 < nm) {
#pragma unroll
                    for (int e = 0; e < 8; ++e) { const unsigned pk = bpk[m8 * 4 + (e >> 1)]; const int bin = (e & 1) ? (int)(pk >> 16) : (int)(pk & 0xFFFFu);
                        const bool pred = bin == B; const unsigned long long bm = __ballot(pred);
                        if (bm) {
                            const unsigned key = u[m8 * 8 + e];
                            if (pred) { const int pos = M + (int)__builtin_amdgcn_mbcnt_hi((unsigned)(bm >> 32), __builtin_amdgcn_mbcnt_lo((unsigned)bm, 0u)); if (pos < 256) cand[pos] = key; }
                            M += __popcll(bm); } }
                }
                WAVE_LDS_SYNC();
                bool done = false;
                if (M <= 256 && om != 0ull) {
                    for (int c0 = 0; c0 < M; c0 += 64) {
                        const bool act = c0 + lane < M; const unsigned x = act ? cand[c0 + lane] : 0u; int gt = 0, ge = 0;
                        for (int i = 0; i < M; ++i) { const unsigned y = cand[i]; gt += (y > x) ? 1 : 0; ge += (y >= x) ? 1 : 0; }
                        const unsigned long long hm = __ballot(act && gt < r && r <= ge);
                        if (hm) { T = (unsigned)__builtin_amdgcn_readlane((int)x, __ffsll((long long)hm) - 1); done = true; }
                    }
                }
                if (!done) {
                    T = 0u;
                    for (int bit = 31; bit >= 0; --bit) {
                        const unsigned Tc = T | (1u << bit); int cnt = 0;
#pragma unroll
                        for (int m8 = 0; m8 < 8; ++m8) if (m8 * 8 < nm) {
#pragma unroll
                            for (int e = 0; e < 8; ++e) cnt += __popcll(__ballot(u[m8 * 8 + e] >= Tc));
                        }
                        if (cnt >= 256) T = Tc;
                    }
                }
                WAVE_LDS_SYNC();
            }
            if (T == 0u) T = 1u;
            unsigned long long w = 0ull;
#pragma unroll
            for (int m = 0; m < 64; ++m) { const unsigned long long bal = __ballot(u[m] >= T); w = (lane == m) ? bal : w; if ((m & 7) == 7) __builtin_amdgcn_sched_barrier(0); }
            MASK[(size_t)row * 64 + lane] = w;
        }
    }
    SEAM(8)
    PHASE(9) {
        h16* KS = (h16*)shm;
        h16* VT = (h16*)(shm + 2 * 64 * 136 * 2);
        const int ql = lane & 31, hf = lane >> 5;
        for (int pi = blockIdx.x; pi < 256; pi += gridDim.x) {
            const int xq = pi & 7, iq = pi >> 3, rr = iq & 7;
            const int b = xq >> 1, h = 4 * (xq & 1) + (iq >> 3);
#pragma unroll 1
            for (int side = 0; side < 2; ++side) {
                const int qb = side ? 15 - rr : rr, nkt = 4 * qb + 4, cw = 4 * qb + (wave >> 1);
                const size_t tokq = (size_t)b * SEQ + qb * 256 + wave * 32 + ql;
                h16x8 qf[8];
#pragma unroll
                for (int ks = 0; ks < 8; ++ks) qf[ks] = *(const h16x8*)(P16 + tokq * 5120 + 2048 + h * 128 + 16 * ks + 8 * hf);
                f32x16 O[4];
#pragma unroll
                for (int dt = 0; dt < 4; ++dt)
#pragma unroll
                    for (int i = 0; i < 16; ++i) O[dt][i] = 0.f;
                float mrow = -1e30f, lrow = 0.f;
                unsigned long long mwn = MASK[tokq * 64];
                h16x8 kreg[2], vreg[2];
                const size_t kvbase = (size_t)b * SEQ * 5120 + h * 128;
                const h16* vtbase = VTG + ((size_t)b * 8 + h) * 128 * SEQ;
#pragma unroll
                for (int i = 0; i < 2; ++i) { const int pc = tid + 512 * i;
                    kreg[i] = *(const h16x8*)(P16 + kvbase + (size_t)(pc >> 4) * 5120 + 3072 + (pc & 15) * 8);
                    vreg[i] = *(const h16x8*)(vtbase + (size_t)(pc >> 3) * SEQ + (pc & 7) * 8); }
                __syncthreads();
#pragma unroll
                for (int i = 0; i < 2; ++i) { const int pc = tid + 512 * i;
                    *(h16x8*)(KS + (pc >> 4) * 136 + (pc & 15) * 8) = kreg[i];
                    *(h16x8*)(VT + (pc >> 3) * 72 + (pc & 7) * 8) = vreg[i]; }
                __syncthreads();
                for (int kt = 0; kt < nkt; ++kt) {
                    const int cur = kt & 1;
                    const unsigned long long mw = mwn;
                    if (kt + 1 < nkt) mwn = MASK[tokq * 64 + kt + 1];
                    if (kt + 1 < nkt) {
#pragma unroll
                        for (int i = 0; i < 2; ++i) { const int pc = tid + 512 * i; const size_t kb = kvbase + (size_t)(64 * (kt + 1)) * 5120;
                            kreg[i] = *(const h16x8*)(P16 + kb + (size_t)(pc >> 4) * 5120 + 3072 + (pc & 15) * 8);
                            vreg[i] = *(const h16x8*)(vtbase + (size_t)(pc >> 3) * SEQ + 64 * (kt + 1) + (pc & 7) * 8); }
                    }
                    if (kt <= cw) {
                        const h16* ksb = KS + cur * (64 * 136); const h16* vtb = VT + cur * (128 * 72);
                        const unsigned msk[2] = {~((unsigned)mw >> (4 * hf)), ~((unsigned)(mw >> 32) >> (4 * hf))};
                        f32x16 s[2];
#pragma unroll
                        for (int sub = 0; sub < 2; ++sub) {
#pragma unroll
                            for (int i = 0; i < 16; ++i) {
                                const int t = __builtin_amdgcn_sbfe((int)msk[sub], 8 * (i >> 2) + (i & 3), 1);
                                s[sub][i] = __builtin_bit_cast(float, t & (int)0xf149f2ca); }
#pragma unroll
                            for (int ks = 0; ks < 8; ++ks) { const h16x8 kfr = *(const h16x8*)(ksb + (32 * sub + ql) * 136 + 16 * ks + 8 * hf);
                                s[sub] = __builtin_amdgcn_mfma_f32_32x32x16_f16(kfr, qf[ks], s[sub], 0, 0, 0); }
                        }
                        float mx = -1e30f;
#pragma unroll
                        for (int sub = 0; sub < 2; ++sub)
#pragma unroll
                            for (int i = 0; i < 16; ++i) mx = fmaxf(mx, s[sub][i]);
                        mx = fmaxf(mx, __shfl_xor(mx, 32));
                        if (__any(mx - mrow > 11.5f)) {
                            const float mnew2 = fmaxf(mrow, mx);
                            const float alpha = __builtin_amdgcn_exp2f(mrow - mnew2);
                            lrow *= alpha;
#pragma unroll
                            for (int dt = 0; dt < 4; ++dt)
#pragma unroll
                                for (int i = 0; i < 16; ++i) O[dt][i] *= alpha;
                            mrow = mnew2;
                        }
                        const float mnew = mrow;
#pragma unroll
                        for (int sub = 0; sub < 2; ++sub) {
                            h16x8 pf[2];
#pragma unroll
                            for (int i = 0; i < 16; ++i) { const float pv = __builtin_amdgcn_exp2f(s[sub][i] - mnew); lrow += pv; pf[i >> 3][i & 7] = (h16)pv; }
#pragma unroll
                            for (int j = 0; j < 2; ++j)
#pragma unroll
                                for (int dt = 0; dt < 4; ++dt) { const h16x8 vfr = *(const h16x8*)(vtb + (32 * dt + ql) * 72 + 32 * sub + 16 * j + 8 * hf);
                                    O[dt] = __builtin_amdgcn_mfma_f32_32x32x16_f16(vfr, pf[j], O[dt], 0, 0, 0); }
                        }
                    }
                    if (kt + 1 < nkt) {
                        h16* ksn = KS + (cur ^ 1) * (64 * 136); h16* vtn = VT + (cur ^ 1) * (128 * 72);
#pragma unroll
                        for (int i = 0; i < 2; ++i) { const int pc = tid + 512 * i;
                            *(h16x8*)(ksn + (pc >> 4) * 136 + (pc & 15) * 8) = kreg[i];
                            *(h16x8*)(vtn + (pc >> 3) * 72 + (pc & 7) * 8) = vreg[i]; }
                    }
                    __syncthreads();
                }
                float lt = lrow + __shfl_xor(lrow, 32);
                const float il = 1.f / lt; float ss = 0.f;
#pragma unroll
                for (int dt = 0; dt < 4; ++dt)
#pragma unroll
                    for (int i = 0; i < 16; ++i) { O[dt][i] *= il; ss += O[dt][i] * O[dt][i]; }
                ss += __shfl_xor(ss, 32);
                const float rstd = rsqrtf(ss * (1.f / 128.f) + EPS);
#pragma unroll
                for (int dt = 0; dt < 4; ++dt)
#pragma unroll
                    for (int i4 = 0; i4 < 4; ++i4) { const int d0 = 32 * dt + 8 * i4 + 4 * hf; const f32x4 gg = *(const f32x4*)(p.ong + 1024 + h * 128 + d0); h16x4 o;
#pragma unroll
                        for (int e = 0; e < 4; ++e) o[e] = (h16)(O[dt][4 * i4 + e] * rstd * gg[e]);
                        *(h16x4*)(H + tokq * DM + 1024 + h * 128 + d0) = o; }
            }
        }
        __syncthreads();
    }
    SEAM(9)
    PHASE(10) { EpiResid<h16, h16> E{X1H, X2H, MOD + 5 * DM, 1.0f}; gemm_phase<4>((LAS unsigned char*)shm, H, WOUT, NT, DM, DM, E); }
    SEAM(10)
    PHASE(11) {
        float* cA = (float*)shm; float* cB = cA + DM;
        auto modv = [MOD](int b, int n) { return MOD[(size_t)b * NMOD + n]; };
        for (int rbi = blockIdx.x; rbi < NT / 64; rbi += gridDim.x) { const int rb = (rbi & 7) * 32 + (rbi >> 3); norm_rows(X2H, p.n3g, 6, 7, H, cA, cB, modv, rb); }
    }
    SEAM(11)
    PHASE(12) { EpiSwiglu E{ACT}; gemm_phase<4>((LAS unsigned char*)shm, H, W13, NT, 2 * FF, DM, E); }
    SEAM(12)
    PHASE(13) { EpiResid<h16, float> E{X2H, p.out, MOD + 8 * DM, 0.5f}; gemm_phase<4>((LAS unsigned char*)shm, ACT, W2, NT, DM, FF, E); }
}

extern "C" void kernel_launch(void* const* d_in, const int* in_sizes, int n_in, void* d_out, int out_size, void* d_ws, size_t ws_size, hipStream_t stream) {
    static int grid = 0;
    if (grid == 0) {
        if (n_in != 22 || ws_size < WS_END) { fprintf(stderr, "kernel_launch: need 22 inputs and %zu bytes of workspace (got %d, %zu)\n", (size_t)WS_END, n_in, ws_size); grid = -1; return; }
        int dev = 0, cus = 0, per_cu = 0;
        hipGetDevice(&dev); hipDeviceGetAttribute(&cus, hipDeviceAttributeMultiprocessorCount, dev);
        hipFuncSetAttribute((const void*)mk_fwd, hipFuncAttributeMaxDynamicSharedMemorySize, LDS_BYTES);
        if (hipOccupancyMaxActiveBlocksPerMultiprocessor(&per_cu, (const void*)mk_fwd, 512, LDS_BYTES) != hipSuccess || per_cu < 1) { fprintf(stderr, "kernel_launch: occupancy query says %d\n", per_cu); per_cu = 1; }
        (void)hipGetLastError();
        grid = cus * (per_cu > 1 ? 1 : per_cu);
        if (grid <= 0) grid = 256;
    }
    if (grid < 0) return;
    Params p{};
    const float** fp = (const float**)&p.x;
    (void)fp;
    p.x = (const float*)d_in[0]; p.c = (const float*)d_in[1]; p.pos = (const int*)d_in[2];
    p.w_ada = (const float*)d_in[3]; p.b_ada = (const float*)d_in[4]; p.n1g = (const float*)d_in[5];
    p.f1w1 = (const float*)d_in[6]; p.f1w3 = (const float*)d_in[7]; p.f1w2 = (const float*)d_in[8];
    p.n2g = (const float*)d_in[9]; p.w_in = (const float*)d_in[10]; p.vg = (const float*)d_in[11];
    p.gws = (const float*)d_in[12]; p.gb = (const float*)d_in[13]; p.qg = (const float*)d_in[14]; p.kg = (const float*)d_in[15];
    p.ong = (const float*)d_in[16]; p.w_out = (const float*)d_in[17]; p.n3g = (const float*)d_in[18];
    p.f2w1 = (const float*)d_in[19]; p.f2w3 = (const float*)d_in[20]; p.f2w2 = (const float*)d_in[21];
    p.out = (float*)d_out; p.ws = (unsigned char*)d_ws;
    for (int i = 0; i < 16; ++i) p.invB[i] = (float)std::pow(500000.0, -2.0 * i / 32.0);
    for (int i = 0; i < 8; ++i) p.invI[i] = (float)std::pow(500000.0, -2.0 * i / 16.0);
#if MK_SINGLE
    if (hipMemsetAsync((char*)d_ws + OFF_BAR, 0, (size_t)XCD_BAR_WORDS_C * 4, stream) != hipSuccess) { fprintf(stderr, "kernel_launch: memset of barrier words failed\n"); return; }
    p.ph_lo = 0; p.ph_hi = NPH;
    void* args[] = {&p};
    hipError_t e = hipLaunchCooperativeKernel((const void*)mk_fwd, dim3(grid), dim3(512), args, LDS_BYTES, stream);
    if (e != hipSuccess) fprintf(stderr, "cooperative launch failed: %s (grid %d)\n", hipGetErrorString(e), grid);
#else
    for (int k = 0; k < NPH; ++k) { p.ph_lo = k; p.ph_hi = k + 1; hipLaunchKernelGGL(mk_fwd, dim3(grid), dim3(512), LDS_BYTES, stream, p); }
#endif
}
```

```cpp
#include <hip/hip_runtime.h>
#include <hip/hip_cooperative_groups.h>
#include <cstdio>
#include <cstdint>
#include <cmath>
namespace cg = cooperative_groups;

#ifndef MK_SINGLE
#define MK_SINGLE 1
#endif

#define LAS __attribute__((address_space(3)))
typedef _Float16 h16;
typedef _Float16 h16x8 __attribute__((ext_vector_type(8)));
typedef _Float16 h16x4 __attribute__((ext_vector_type(4)));
typedef float f32x4 __attribute__((ext_vector_type(4)));
typedef __bf16 b16x8 __attribute__((ext_vector_type(8)));
typedef float f32x16 __attribute__((ext_vector_type(16)));

constexpr int NB = 4, SEQ = 4096, DM = 2048, NT = NB * SEQ, FF = 5632, NIN = 6224, NINP = 6400, NMOD = 9 * DM;
constexpr int NPH = 14;
constexpr int XCD_BAR_WORDS_C = 3456;
constexpr float EPS = 1e-6f;
constexpr int KSL = 32;

constexpr size_t SZ_W13 = (size_t)2 * FF * DM * 2, SZ_W2 = (size_t)DM * FF * 2;
constexpr size_t OFF_W13 = 0, OFF_W2 = OFF_W13 + SZ_W13;
constexpr size_t OFF_WIN = OFF_W2 + SZ_W2, OFF_WOUT = OFF_WIN + (size_t)NINP * DM * 2;
constexpr size_t OFF_ACT = OFF_WOUT + (size_t)DM * DM * 2;
constexpr size_t SC_PER_B = (size_t)4096 * 2080;
constexpr size_t OFF_SC = OFF_ACT, OFF_MASK = OFF_SC + SC_PER_B * 4 * NB, OFF_IQH = OFF_MASK + (size_t)NT * 64 * 8;
constexpr size_t OFF_IKH = OFF_IQH + (size_t)NT * 1024 * 2, OFF_IW = OFF_IKH + (size_t)NT * 64 * 2, END_OVL = OFF_IW + (size_t)NT * 16 * 4;
constexpr size_t OFF_H = OFF_ACT + (size_t)NT * FF * 2;
constexpr size_t OFF_P16 = OFF_H + (size_t)NT * DM * 2;
constexpr size_t OFF_I32 = OFF_P16 + (size_t)NT * 5120 * 2;
constexpr size_t OFF_PART = OFF_I32 + (size_t)NT * 1280 * 4;
constexpr size_t OFF_MOD = OFF_PART + (size_t)KSL * NB * NMOD * 4;
constexpr size_t OFF_CB = OFF_MOD + (size_t)NB * NMOD * 4, OFF_SB = OFF_CB + (size_t)NT * 16 * 4;
constexpr size_t OFF_CI = OFF_SB + (size_t)NT * 16 * 4, OFF_SI = OFF_CI + (size_t)NT * 8 * 4;
constexpr size_t OFF_BAR = OFF_SI + (size_t)NT * 8 * 4;
constexpr size_t WS_END = OFF_BAR + (size_t)XCD_BAR_WORDS_C * 4;
static_assert(END_OVL <= OFF_H, "overlay too large");
constexpr int LDS_BYTES = 131072 + 64;

struct Params {
    const float *x, *c; const int* pos;
    const float *w_ada, *b_ada, *n1g, *f1w1, *f1w3, *f1w2, *n2g, *w_in, *vg, *gws, *gb, *qg, *kg, *ong, *w_out, *n3g, *f2w1, *f2w3, *f2w2;
    float* out; unsigned char* ws;
    float invB[16]; float invI[8];
    int ph_lo, ph_hi;
};

template <int CTRL> __device__ __forceinline__ float dppf(float v) { return __builtin_bit_cast(float, __builtin_amdgcn_update_dpp(0, __builtin_bit_cast(int, v), CTRL, 0xF, 0xF, false)); }
__device__ __forceinline__ float red16(float v) {
    v += dppf<0x128>(v); v += dppf<0x124>(v); v += dppf<0x122>(v); v += dppf<0x121>(v);
    return v;
}
typedef unsigned u32x2_t __attribute__((ext_vector_type(2)));
__device__ __forceinline__ float xor32_sum(float v) { const unsigned b = __builtin_bit_cast(unsigned, v); const u32x2_t r = __builtin_amdgcn_permlane32_swap(b, b, false, false);
    return __builtin_bit_cast(float, r[0]) + __builtin_bit_cast(float, r[1]); }
__device__ __forceinline__ float xor32_max(float v) { const unsigned b = __builtin_bit_cast(unsigned, v); const u32x2_t r = __builtin_amdgcn_permlane32_swap(b, b, false, false);
    return fmaxf(__builtin_bit_cast(float, r[0]), __builtin_bit_cast(float, r[1])); }
__device__ __forceinline__ float wave_sum(float v) { v = red16(v); v += __shfl_xor(v, 16); v += __shfl_xor(v, 32); return v; }
__device__ __forceinline__ float gelu_t(float x) { const float u = 0.7978845608028654f * (x + 0.044715f * x * x * x); return x * __builtin_amdgcn_rcpf(1.f + __builtin_amdgcn_exp2f(-2.885390081777927f * u)); }
__device__ __forceinline__ float silu_f(float a) { return a * __builtin_amdgcn_rcpf(1.f + __builtin_amdgcn_exp2f(-1.4426950408889634f * a)); }
__device__ __forceinline__ int binof(unsigned u) {
    const unsigned bits = (u & 0x80000000u) ? (u ^ 0x80000000u) : ~u; const float s = __builtin_bit_cast(float, bits);
    return (int)fminf(fmaxf(s * 64.f + 1024.f, 0.f), 2047.f);
}
#define WAVE_LDS_SYNC() asm volatile("s_waitcnt lgkmcnt(0)" ::: "memory")

constexpr int BM = 256, BK = 64, HALF = 128, HTB = HALF * BK * 2, NXCD = 8;
__host__ __device__ __forceinline__ int lds_byte(int r, int c) { const int st = (r >> 4) * 2 + (c >> 5), rr = r & 15, cc = c & 31, ob = rr * 64 + cc * 2; return st * 1024 + (ob ^ (((ob >> 9) & 1) << 5)); }
__host__ __device__ __forceinline__ void stage_rc(int b, int& R, int& C) { const int st = b / 1024, sb = b % 1024, swz = sb ^ (((sb >> 9) & 1) << 5); R = (st >> 1) * 16 + swz / 64; C = (st & 1) * 32 + (swz % 64) / 2; }
__host__ __device__ __forceinline__ int perm32(int rho) { const int n = rho >> 4, i = rho & 15; return 8 * (i >> 2) + 4 * n + (i & 3); }
struct Unit { int pm, pn; };
template <int WGM> struct StaticOrder {
    int nM, nN, nwg, G, c;
    __device__ void init(int M, int N, int G_, int c_) { nM = M / BM; nN = N / BM; nwg = nM * nN; G = G_; c = c_; }
    __device__ bool next(int i, Unit& u) const {
        const long L = (long)i * G + c; if (L >= nwg) return false;
        int wgid = (int)L; { const int q = nwg / NXCD, r = nwg % NXCD, xcd = wgid % NXCD, off = wgid / NXCD; wgid = (xcd < r ? xcd * (q + 1) : r * (q + 1) + (xcd - r) * q) + off; }
        const int nig = WGM * nN, gid = wgid / nig, fm = gid * WGM, gsz = (nM - fm) < WGM ? (nM - fm) : WGM;
        u.pm = fm + ((wgid % nig) % gsz); u.pn = (wgid % nig) / gsz; return true;
    }
};

struct EpiSwiglu {
    static constexpr bool PERM = true;
    h16* O;
    __device__ __forceinline__ void operator()(const f32x4 (&acc)[2][2][4][2], const Unit& u, int wr, int wc, int fr, int fq) const {
        const int row0 = u.pm * BM + wr * 64 + fr, col0 = u.pn * 128 + wc * 32 + 8 * fq;
#pragma unroll
        for (int ai = 0; ai < 2; ++ai)
#pragma unroll
            for (int m = 0; m < 4; ++m) {
                h16* rowp = O + (size_t)(row0 + ai * HALF + m * 16) * FF + col0;
                h16x8 o;
#pragma unroll
                for (int n = 0; n < 2; ++n)
#pragma unroll
                    for (int j = 0; j < 4; ++j) o[n * 4 + j] = (h16)(silu_f(acc[ai][0][m][n][j]) * acc[ai][1][m][n][j]);
                *(h16x8*)rowp = o;
            }
    }
};
template <class RT, class OT> struct EpiResid {
    static constexpr bool PERM = true;
    const RT* res; OT* out; const float* gate; float coef;
    __device__ __forceinline__ void operator()(const f32x4 (&acc)[2][2][4][2], const Unit& u, int wr, int wc, int fr, int fq) const {
        const int row0 = u.pm * BM + wr * 64 + fr, col0 = u.pn * BM + wc * 32 + 8 * fq, b = u.pm >> 4;
        f32x4 gv[2][2];
#pragma unroll
        for (int bj = 0; bj < 2; ++bj)
#pragma unroll
            for (int n = 0; n < 2; ++n) gv[bj][n] = *(const f32x4*)(gate + (size_t)b * NMOD + col0 + bj * HALF + 4 * n) * coef;
#pragma unroll
        for (int ai = 0; ai < 2; ++ai)
#pragma unroll
            for (int m = 0; m < 4; ++m) {
                const size_t ro = (size_t)(row0 + ai * HALF + m * 16) * DM + col0;
#pragma unroll
                for (int bj = 0; bj < 2; ++bj) {
                    f32x4 r0, r1;
                    if constexpr (sizeof(RT) == 4) { r0 = *(const f32x4*)((const float*)res + ro + bj * HALF); r1 = *(const f32x4*)((const float*)res + ro + bj * HALF + 4); }
                    else { const h16x8 rr = *(const h16x8*)((const h16*)res + ro + bj * HALF);
#pragma unroll
                        for (int e2 = 0; e2 < 4; ++e2) { r0[e2] = (float)rr[e2]; r1[e2] = (float)rr[4 + e2]; } }
                    const f32x4 v0 = r0 + gv[bj][0] * acc[ai][bj][m][0], v1 = r1 + gv[bj][1] * acc[ai][bj][m][1];
                    if constexpr (sizeof(OT) == 4) { *(f32x4*)((float*)out + ro + bj * HALF) = v0; *(f32x4*)((float*)out + ro + bj * HALF + 4) = v1; }
                    else { h16x8 o;
#pragma unroll
                        for (int e2 = 0; e2 < 4; ++e2) { o[e2] = (h16)v0[e2]; o[4 + e2] = (h16)v1[e2]; }
                        *(h16x8*)((h16*)out + ro + bj * HALF) = o; }
                }
            }
    }
};
struct EpiNull { static constexpr bool PERM = true; float* sink;
    __device__ __forceinline__ void operator()(const f32x4 (&acc)[2][2][4][2], const Unit& u, int wr, int wc, int fr, int fq) const {
        float s = 0.f;
#pragma unroll
        for (int a = 0; a < 2; ++a)
#pragma unroll
            for (int b = 0; b < 2; ++b)
#pragma unroll
                for (int m = 0; m < 4; ++m)
#pragma unroll
                    for (int n = 0; n < 2; ++n) s += (acc[a][b][m][n][0] + acc[a][b][m][n][1]) + (acc[a][b][m][n][2] + acc[a][b][m][n][3]);
        if (s == 1.2345e30f) sink[0] = s; }
};
struct EpiProj {
    static constexpr bool PERM = false;
    h16* P16; h16* IQH; h16* IKH; float* IW; const float* COSI; const float* SINI; h16* VTG;
    __device__ __forceinline__ void operator()(const f32x4 (&acc)[2][2][4][2], const Unit& u, int wr, int wc, int fr, int fq) const {
        const int row0 = u.pm * BM + wr * 64 + fr;
        if (u.pn >= 16 && u.pn < 20) {
            const int b = u.pm >> 4, tokb = (u.pm & 15) * BM + wc * 32, p4 = 4 * ((fq & 1) * 2 + (fq >> 1));
#pragma unroll
            for (int ai = 0; ai < 2; ++ai)
#pragma unroll
                for (int m = 0; m < 4; ++m) {
                    const int head = (u.pn - 16) * 2 + ai, d = wr * 64 + m * 16 + fr;
                    h16* drow = VTG + (((size_t)b * 8 + head) * 128 + d) * SEQ + tokb + p4;
#pragma unroll
                    for (int bj = 0; bj < 2; ++bj)
#pragma unroll
                        for (int n = 0; n < 2; ++n) {
                            h16x4 o; const f32x4 v = acc[ai][bj][m][n];
                            o[0] = (h16)v[0]; o[1] = (h16)v[1]; o[2] = (h16)v[2]; o[3] = (h16)v[3];
                            *(h16x4*)(drow + bj * HALF + n * 16) = o;
                        }
                }
        } else if (u.pn < 20) {
            const int col0 = u.pn * BM + wc * 32 + 4 * fq; const bool act = u.pn < 4;
#pragma unroll
            for (int ai = 0; ai < 2; ++ai)
#pragma unroll
                for (int m = 0; m < 4; ++m) {
                    h16* rowp = P16 + (size_t)(row0 + ai * HALF + m * 16) * 5120 + col0;
#pragma unroll
                    for (int bj = 0; bj < 2; ++bj)
#pragma unroll
                        for (int n = 0; n < 2; ++n) {
                            h16x4 o; f32x4 v = acc[ai][bj][m][n];
                            if (act) {
#pragma unroll
                                for (int e = 0; e < 4; ++e) v[e] = gelu_t(v[e]);
                            }
                            o[0] = (h16)v[0]; o[1] = (h16)v[1]; o[2] = (h16)v[2]; o[3] = (h16)v[3];
                            *(h16x4*)(rowp + bj * HALF + n * 16) = o;
                        }
                }
        } else {
            const bool isk = u.pn == 24;
            const bool rot = isk ? (wc == 0) : ((wc & 1) == 0);
#pragma unroll
            for (int ai = 0; ai < 2; ++ai)
#pragma unroll
                for (int m = 0; m < 4; ++m) {
                    const size_t row = (size_t)(row0 + ai * HALF + m * 16);
                    f32x4 cs = (f32x4){1.f, 1.f, 1.f, 1.f}, sn = (f32x4){0.f, 0.f, 0.f, 0.f};
                    if (rot) { cs = *(const f32x4*)(COSI + row * 8 + 4 * (fq & 1)); sn = *(const f32x4*)(SINI + row * 8 + 4 * (fq & 1)); }
#pragma unroll
                    for (int bj = 0; bj < 2; ++bj) {
                        if (isk && bj == 1) continue;
#pragma unroll
                        for (int n = 0; n < 2; ++n) {
                            f32x4 v = acc[ai][bj][m][n];
                            if (n == 0 && rot) {
                                f32x4 pv;
#pragma unroll
                                for (int e = 0; e < 4; ++e) pv[e] = __shfl_xor(v[e], 32);
#pragma unroll
                                for (int e = 0; e < 4; ++e) v[e] = (fq < 2) ? v[e] * cs[e] - pv[e] * sn[e] : v[e] * cs[e] + pv[e] * sn[e];
                            }
                            if (!isk) {
                                h16x4 o; o[0] = (h16)v[0]; o[1] = (h16)v[1]; o[2] = (h16)v[2]; o[3] = (h16)v[3];
                                *(h16x4*)(IQH + row * 1024 + (u.pn - 20) * BM + bj * HALF + wc * 32 + n * 16 + 4 * fq) = o;
                            } else if (wc < 2) {
                                h16x4 o; o[0] = (h16)v[0]; o[1] = (h16)v[1]; o[2] = (h16)v[2]; o[3] = (h16)v[3];
                                *(h16x4*)(IKH + row * 64 + wc * 32 + n * 16 + 4 * fq) = o;
                            } else if (wc == 2 && n == 0) {
                                *(f32x4*)(IW + row * 16 + 4 * fq) = v * 0.03125f;
                            }
                        }
                    }
                }
        }
    }
};

template <int WGM, class Epi, bool SAME = false, int SKIP_PN = -1, bool BF16 = false, int SWAP_LO = -1, int SWAP_HI = -1>
__device__ __forceinline__ void gemm_phase(LAS unsigned char* lds, const h16* Ag, const h16* Btg, int M, int N, int K, const Epi& E) {
    const int tid = threadIdx.x, wid = __builtin_amdgcn_readfirstlane(tid >> 6), lane = tid & 63, wr = wid >> 2, wc = wid & 3, fr = lane & 15, fq = lane >> 4;
    const int nt = K / BK;
    StaticOrder<WGM> S; S.init(M, N, (int)gridDim.x, (int)blockIdx.x);
    unsigned voffA[2], voffB[2];
#pragma unroll
    for (int i = 0; i < 2; ++i) { int R, C; stage_rc(tid * 16 + i * 8192, R, C); const int Rb = Epi::PERM ? ((R & ~31) + perm32(R & 31)) : R;
        voffA[i] = (unsigned)(R * K + C) * 2u; voffB[i] = (unsigned)(Rb * K + C) * 2u; }
    const size_t kstep = (size_t)(BK * 2);
    const size_t hstep = (size_t)HALF * K * 2;
    const size_t tstep = 2 * hstep;
    const unsigned ldsw = (unsigned)wid * 1024u;
    const int aoff = lds_byte(wr * 64 + fr, fq * 8), boff = lds_byte(wc * 32 + fr, fq * 8);
#define PG8_SA(b, h) (((b) * 2 + (h)) * HTB)
#define PG8_SB(b, h) ((4 + (b) * 2 + (h)) * HTB)
#define PG8_STAGE(bufoff, gbase, voff) do { _Pragma("unroll") for (int _i = 0; _i < 2; ++_i) \
        __builtin_amdgcn_global_load_lds((const unsigned*)((const char*)(gbase) + (voff)[_i]), (LAS unsigned*)(lds + (bufoff) + ldsw + _i * 8192), 16, 0, 0); } while (0)
#define PG8_LDA(dst, b, h) do { _Pragma("unroll") for (int m = 0; m < 4; ++m) _Pragma("unroll") for (int k = 0; k < 2; ++k) dst[m][k] = *(const LAS h16x8*)(lds + PG8_SA(b, h) + aoff + m * 2048 + k * 1024); } while (0)
#define PG8_LDB(dst, b, h) do { _Pragma("unroll") for (int n = 0; n < 2; ++n) _Pragma("unroll") for (int k = 0; k < 2; ++k) dst[n][k] = *(const LAS h16x8*)(lds + PG8_SB(b, h) + boff + n * 2048 + k * 1024); } while (0)
#define PG8_MMA(ai, bj, At, Bt) do { __builtin_amdgcn_s_setprio(1); _Pragma("unroll") for (int m = 0; m < 4; ++m) _Pragma("unroll") for (int n = 0; n < 2; ++n) _Pragma("unroll") for (int k = 0; k < 2; ++k) \
        acc[ai][bj][m][n] = BF16 ? __builtin_amdgcn_mfma_f32_16x16x32_bf16(__builtin_bit_cast(b16x8, Bt[n][k]), __builtin_bit_cast(b16x8, At[m][k]), acc[ai][bj][m][n], 0, 0, 0) : __builtin_amdgcn_mfma_f32_16x16x32_f16(Bt[n][k], At[m][k], acc[ai][bj][m][n], 0, 0, 0); __builtin_amdgcn_s_setprio(0); } while (0)
#define PG8_WAIT_V(n) asm volatile("s_waitcnt vmcnt(" #n ")" ::: "memory")
#define PG8_WAIT_L(n) asm volatile("s_waitcnt lgkmcnt(" #n ")" ::: "memory")
#define PG8_BAR __builtin_amdgcn_s_barrier()
#define PG8_SCHED __builtin_amdgcn_sched_barrier(0)
    Unit cur, nxt; int ui = 0;
    if (!S.next(0, cur)) return;
    if (SAME) { cur.pm = 0; cur.pn = 0; }
    f32x4 acc[2][2][4][2];
#pragma unroll
    for (int a = 0; a < 2; ++a)
#pragma unroll
        for (int b = 0; b < 2; ++b)
#pragma unroll
            for (int m = 0; m < 4; ++m)
#pragma unroll
                for (int n = 0; n < 2; ++n) acc[a][b][m][n] = (f32x4){0.f, 0.f, 0.f, 0.f};
    h16x8 At[4][2], B0[2][2], B1[2][2];
#define PG8_SWP(u_) ((SWAP_LO >= 0) && (u_).pn >= SWAP_LO && (u_).pn < SWAP_HI)
    const char* cA = PG8_SWP(cur) ? (const char*)Btg + (size_t)cur.pn * tstep : (const char*)Ag + (size_t)cur.pm * tstep;
    const char* cB = PG8_SWP(cur) ? (const char*)Ag + (size_t)cur.pm * tstep : (const char*)Btg + (size_t)cur.pn * tstep;
    PG8_STAGE(PG8_SB(0, 0), cB, voffB); PG8_STAGE(PG8_SA(0, 0), cA, voffA); PG8_STAGE(PG8_SB(0, 1), cB + hstep, voffB); PG8_STAGE(PG8_SA(0, 1), cA + hstep, voffA);
    if (wr == 1) PG8_BAR;
    PG8_WAIT_V(4); PG8_BAR;
    PG8_STAGE(PG8_SB(1, 0), cB + kstep, voffB); PG8_STAGE(PG8_SA(1, 0), cA + kstep, voffA); PG8_STAGE(PG8_SB(1, 1), cB + hstep + kstep, voffB);
    PG8_WAIT_V(6); PG8_BAR;
    for (;;) {
        const bool has_next = S.next(ui + 1, nxt);
        if (SAME) { nxt.pm = 0; nxt.pn = 0; }
        const char* nA = has_next ? (PG8_SWP(nxt) ? (const char*)Btg + (size_t)nxt.pn * tstep : (const char*)Ag + (size_t)nxt.pm * tstep) : cA;
        const char* nB = has_next ? (PG8_SWP(nxt) ? (const char*)Ag + (size_t)nxt.pm * tstep : (const char*)Btg + (size_t)nxt.pn * tstep) : cB;
        const bool skipb1 = (SKIP_PN >= 0) && (cur.pn == SKIP_PN);
        for (int t = 0; t < nt; t += 2) {
            const bool last = (t == nt - 2);
            const char* a1 = cA + (size_t)(t + 1) * kstep;
            const char* a2 = last ? nA : cA + (size_t)(t + 2) * kstep; const char* b2 = last ? nB : cB + (size_t)(t + 2) * kstep;
            const char* a3 = a2 + kstep; const char* b3 = b2 + kstep;
            PG8_LDB(B0, 0, 0); PG8_SCHED; PG8_LDA(At, 0, 0); PG8_STAGE(PG8_SA(1, 1), a1 + hstep, voffA);
            PG8_WAIT_L(8); PG8_BAR; PG8_WAIT_L(0); PG8_MMA(0, 0, At, B0); PG8_BAR; PG8_SCHED;
            PG8_LDB(B1, 0, 1); PG8_STAGE(PG8_SB(0, 0), b2, voffB);
            PG8_BAR; PG8_WAIT_L(0); if (!skipb1) PG8_MMA(0, 1, At, B1); PG8_BAR;
            PG8_LDA(At, 0, 1); PG8_STAGE(PG8_SA(0, 0), a2, voffA);
            PG8_BAR; PG8_WAIT_L(0); PG8_MMA(1, 0, At, B0); PG8_BAR; PG8_SCHED;
            PG8_STAGE(PG8_SB(0, 1), b2 + hstep, voffB);
            PG8_WAIT_V(6); PG8_BAR; if (!skipb1) PG8_MMA(1, 1, At, B1); PG8_BAR;
            PG8_LDB(B0, 1, 0); PG8_SCHED; PG8_LDA(At, 1, 0); PG8_STAGE(PG8_SA(0, 1), a2 + hstep, voffA);
            PG8_WAIT_L(8); PG8_BAR; PG8_WAIT_L(0); PG8_MMA(0, 0, At, B0); PG8_BAR; PG8_SCHED;
            PG8_LDB(B1, 1, 1); PG8_STAGE(PG8_SB(1, 0), b3, voffB);
            PG8_BAR; PG8_WAIT_L(0); if (!skipb1) PG8_MMA(0, 1, At, B1); PG8_BAR;
            PG8_LDA(At, 1, 1); PG8_STAGE(PG8_SA(1, 0), a3, voffA);
            PG8_BAR; PG8_WAIT_L(0); PG8_MMA(1, 0, At, B0); PG8_BAR; PG8_SCHED;
            PG8_STAGE(PG8_SB(1, 1), b3 + hstep, voffB);
            PG8_WAIT_V(6); PG8_BAR; if (!skipb1) PG8_MMA(1, 1, At, B1); PG8_BAR;
        }
        E(acc, cur, wr, wc, fr, fq);
        if (!has_next) break;
#pragma unroll
        for (int a = 0; a < 2; ++a)
#pragma unroll
            for (int b = 0; b < 2; ++b)
#pragma unroll
                for (int m = 0; m < 4; ++m)
#pragma unroll
                    for (int n = 0; n < 2; ++n) acc[a][b][m][n] = (f32x4){0.f, 0.f, 0.f, 0.f};
        cur = nxt; cA = nA; cB = nB; ++ui;
    }
    PG8_WAIT_V(0);
    if (wr == 0) PG8_BAR;
    PG8_BAR;
#undef PG8_SWP
#undef PG8_SA
#undef PG8_SB
#undef PG8_STAGE
#undef PG8_LDA
#undef PG8_LDB
#undef PG8_MMA
#undef PG8_WAIT_V
#undef PG8_WAIT_L
#undef PG8_BAR
#undef PG8_SCHED
}

__device__ __forceinline__ void transpose_item(const float* W, int K, int N, int nvalid, h16* WT, int dst_row0, int k0, int n0, float* scr, int lane) {
    const int n4 = (lane & 7) * 4; const bool okn = n0 + n4 < nvalid;
    f32x4 tv[8];
#pragma unroll
    for (int i = 0; i < 8; ++i) { const int kk = 8 * i + (lane >> 3); tv[i] = okn ? *(const f32x4*)(W + (size_t)(k0 + kk) * N + n0 + n4) : (f32x4){0.f, 0.f, 0.f, 0.f}; }
#pragma unroll
    for (int i = 0; i < 8; ++i) { const int kk = 8 * i + (lane >> 3);
#pragma unroll
        for (int e = 0; e < 4; ++e) scr[kk * 33 + n4 + e] = tv[i][e]; }
    WAVE_LDS_SYNC();
    const int c = lane & 7;
#pragma unroll
    for (int j = 0; j < 4; ++j) { const int n = (lane >> 3) + 8 * j; const float* s = scr + (8 * c) * 33 + n;
        h16x8 o;
#pragma unroll
        for (int e = 0; e < 8; ++e) o[e] = (h16)s[e * 33];
        *(h16x8*)(WT + (size_t)(dst_row0 + n) * K + k0 + 8 * c) = o; }
    WAVE_LDS_SYNC();
}
__device__ __forceinline__ void convert_ffn(const float* w1, const float* w3, const float* w2, h16* W13, h16* W2, float* scr, int gw, int NGW, int lane) {
    constexpr int I13 = (DM / 64) * (FF / 32);
    constexpr int I2 = (FF / 64) * (DM / 32);
    for (int it = gw; it < 2 * I13 + I2; it += NGW) {
        if (it < 2 * I13) { const int hf = it >= I13, r = hf ? it - I13 : it; const int kb = r / (FF / 32), nb = r % (FF / 32), n0 = nb * 32;
            transpose_item(hf ? w3 : w1, DM, FF, FF, W13, (n0 >> 7) * 256 + hf * 128 + (n0 & 127), kb * 64, n0, scr, lane); }
        else { const int r = it - 2 * I13; const int kb = r / (DM / 32), nb = r % (DM / 32);
            transpose_item(w2, FF, DM, DM, W2, nb * 32, kb * 64, nb * 32, scr, lane); }
    }
}

template <class XT, class ModF>
__device__ __forceinline__ void norm_rows(const XT* X, const float* gain, int shift_i, int scale_i, h16* Hout, float* cA, float* cB, ModF modv, int rb) {
    const int tid = threadIdx.x, lane = tid & 63, wave = tid >> 6, b = rb >> 6;
    f32x4 nv[8];
#define NR_LOAD(row_) do { _Pragma("unroll") for (int j = 0; j < 8; ++j) { \
        if constexpr (sizeof(XT) == 4) nv[j] = ((const f32x4*)((const float*)X + (row_) * DM) + lane)[64 * j]; \
        else { const h16x4 hv_ = ((const h16x4*)((const h16*)X + (row_) * DM) + lane)[64 * j]; nv[j] = (f32x4){(float)hv_[0], (float)hv_[1], (float)hv_[2], (float)hv_[3]}; } } } while (0)
    NR_LOAD((size_t)rb * 64 + wave);
    for (int c = tid; c < DM; c += 512) { const float sc = modv(b, scale_i * DM + c), sh = modv(b, shift_i * DM + c); cA[c] = gain[c] * (1.f + sc); cB[c] = sh; }
    __syncthreads();
    for (int r = wave; r < 64; r += 8) {
        const size_t row = (size_t)rb * 64 + r;
        f32x4 v[8]; float ss = 0.f;
#pragma unroll
        for (int j = 0; j < 8; ++j) { v[j] = nv[j]; ss += (v[j][0] * v[j][0] + v[j][1] * v[j][1]) + (v[j][2] * v[j][2] + v[j][3] * v[j][3]); }
        if (r + 8 < 64) NR_LOAD(row + 8);
        const float rstd = rsqrtf(wave_sum(ss) * (1.f / DM) + EPS);
#pragma unroll
        for (int j = 0; j < 8; ++j) { const int c0 = 4 * lane + 256 * j; const f32x4 a = *(const f32x4*)(cA + c0), bb = *(const f32x4*)(cB + c0);
            h16x4 o;
#pragma unroll
            for (int e = 0; e < 4; ++e) o[e] = (h16)(v[j][e] * rstd * a[e] + bb[e]);
            *(h16x4*)(Hout + row * DM + c0) = o; }
    }
    __syncthreads();
#undef NR_LOAD
}


#define XB_TMO      128
#define XB_XCNT(j)  (256  + 64 * (j))
#define XB_XSUB(j)  (1280 + 64 * (j))
#define XB_XGEN(j)  (2304 + 64 * (j))
#define XB_TOP      3328
#define XB_TOPGEN   3392
#define XCD_BAR_WORDS 3456
#define XB_SPIN_CAP (1u << 18)
__device__ __forceinline__ unsigned xb_ld(unsigned* p)              { return __hip_atomic_load(p, __ATOMIC_RELAXED, __HIP_MEMORY_SCOPE_AGENT); }
__device__ __forceinline__ unsigned xb_add(unsigned* p, unsigned v) { return __hip_atomic_fetch_add(p, v, __ATOMIC_RELAXED, __HIP_MEMORY_SCOPE_AGENT); }
__device__ __forceinline__ unsigned xb_xcc_id() { return (unsigned)__builtin_amdgcn_s_getreg((3 << 11) | 20) & 0xFu; }
#define XB_SPIN(cond, bar) do { unsigned _sp = 0; while (cond) { __builtin_amdgcn_s_sleep(1); \
    if ((++_sp & 255u) == 0u) { if (xb_ld(&(bar)[XB_TMO])) break; if (_sp > XB_SPIN_CAP) { atomicAdd(&(bar)[XB_TMO], 1u); break; } } } } while (0)
struct XcdBarrier { unsigned* bar; unsigned x; volatile LAS unsigned* st; };
__device__ __forceinline__ XcdBarrier xcd_barrier_post(unsigned* bar, volatile LAS unsigned* st) {
    XcdBarrier b; b.bar = bar; b.x = xb_xcc_id(); b.st = st;
    if (threadIdx.x == 0) (void)xb_add(&bar[XB_XCNT(b.x)], 1u);
    return b;
}
__device__ __forceinline__ void xcd_barrier_complete(unsigned* bar, unsigned x, unsigned& nloc, unsigned& nx) {
    const unsigned G = gridDim.x * gridDim.y * gridDim.z;
    unsigned sum, cnt, mine, sp = 0u;
    for (;;) {
        sum = 0u; cnt = 0u; mine = 0u;
#pragma unroll
        for (unsigned j = 0; j < 16; ++j) { const unsigned c = xb_ld(&bar[XB_XCNT(j)]); sum += c; cnt += (c > 0u) ? 1u : 0u; mine = (j == x) ? c : mine; }
        if (sum == G) break;
        __builtin_amdgcn_s_sleep(1);
        if ((++sp & 255u) == 0u) { if (xb_ld(&bar[XB_TMO])) break; if (sp > XB_SPIN_CAP) { atomicAdd(&bar[XB_TMO], 1u); break; } }
    }
    nloc = mine > 0u ? mine : 1u; nx = cnt > 0u ? cnt : 1u;
}
__device__ __forceinline__ void xcd_barrier(const XcdBarrier& b) {
    asm volatile("s_waitcnt vmcnt(0)" ::: "memory");
    __syncthreads();
    if (threadIdx.x == 0) {
        unsigned* bar = b.bar;
        __builtin_amdgcn_s_waitcnt(0);
        unsigned nloc = b.st[0], nx = b.st[1];
        if (nloc == 0u) { xcd_barrier_complete(bar, b.x, nloc, nx); b.st[0] = nloc; b.st[1] = nx; }
        const unsigned old = xb_add(&bar[XB_XSUB(b.x)], 1u);
        const unsigned gen = old / nloc;
        if (old + 1u == (gen + 1u) * nloc) {
            __builtin_amdgcn_fence(__ATOMIC_RELEASE, "agent");
            asm volatile("s_waitcnt vmcnt(0)" ::: "memory");
            const unsigned og = xb_add(&bar[XB_TOP], 1u);
            const unsigned tg = og / nx;
            if (og + 1u == (tg + 1u) * nx) xb_add(&bar[XB_TOPGEN], 1u);
            else XB_SPIN(xb_ld(&bar[XB_TOPGEN]) == tg, bar);
            __builtin_amdgcn_fence(__ATOMIC_ACQUIRE, "agent");
            xb_add(&bar[XB_XGEN(b.x)], 1u);
            asm volatile("s_waitcnt vmcnt(0)" ::: "memory");
        } else {
            XB_SPIN(xb_ld(&bar[XB_XGEN(b.x)]) == gen, bar);
            __builtin_amdgcn_fence(__ATOMIC_ACQUIRE, "agent");
            asm volatile("s_waitcnt vmcnt(0)" ::: "memory");
        }
    }
    __syncthreads();
}

__global__ void __launch_bounds__(512, 2) mk_fwd(Params p) {
    extern __shared__ __attribute__((aligned(16))) unsigned char shm[];
    const int tid = threadIdx.x, lane = tid & 63, wave = tid >> 6;
    const int gw = blockIdx.x * 8 + wave, NGW = gridDim.x * 8;
    unsigned char* ws = p.ws;
    h16* W13 = (h16*)(ws + OFF_W13); h16* W2 = (h16*)(ws + OFF_W2); h16* WIN = (h16*)(ws + OFF_WIN); h16* WOUT = (h16*)(ws + OFF_WOUT);
    h16* ACT = (h16*)(ws + OFF_ACT); float* SC = (float*)(ws + OFF_SC); unsigned long long* MASK = (unsigned long long*)(ws + OFF_MASK);
    h16* IQH = (h16*)(ws + OFF_IQH); h16* IKH = (h16*)(ws + OFF_IKH); float* IW = (float*)(ws + OFF_IW);
    h16* H = (h16*)(ws + OFF_H); h16* P16 = (h16*)(ws + OFF_P16); float* I32 = (float*)(ws + OFF_I32);
    h16* X1H = (h16*)p.out;
    h16* X2H = (h16*)(ws + OFF_P16);
    h16* VTG = (h16*)(ws + OFF_I32);
    float* PART = (float*)(ws + OFF_PART); float* MOD = (float*)(ws + OFF_MOD);
    float* COSB = (float*)(ws + OFF_CB); float* SINB = (float*)(ws + OFF_SB); float* COSI = (float*)(ws + OFF_CI); float* SINI = (float*)(ws + OFF_SI);

    if (tid == 0) { ((volatile LAS unsigned*)(shm + 131072))[0] = 0u; ((volatile LAS unsigned*)(shm + 131072))[1] = 0u; }
    __syncthreads();
    XcdBarrier xbar; xbar.bar = (unsigned*)(ws + OFF_BAR); xbar.x = 0; xbar.st = (volatile LAS unsigned*)(shm + 131072);
    if (p.ph_hi - p.ph_lo > 1) xbar = xcd_barrier_post((unsigned*)(ws + OFF_BAR), (volatile LAS unsigned*)(shm + 131072));
#ifndef PH_MASK
#define PH_MASK 0xFFFF
#endif
#ifndef EXTRA_GEMM
#define EXTRA_GEMM 0
#endif
#ifndef REP_MASK
#define REP_MASK 0
#endif
#define PHASE(k) if (((PH_MASK >> (k)) & 1) && p.ph_lo <= (k) && (k) < p.ph_hi) _Pragma("nounroll") for (int rep_ = 0; rep_ <= ((REP_MASK >> (k)) & 1); ++rep_)
#define SEAM(k) if (p.ph_lo <= (k) && (k) + 1 < p.ph_hi) { if (p.ph_hi > 1000) cg::this_grid().sync(); else xcd_barrier(xbar); }

    PHASE(0) {
        float* scr = (float*)shm + wave * (64 * 33);
        convert_ffn(p.f1w1, p.f1w3, p.f1w2, W13, W2, scr, gw, NGW, lane);
        {   constexpr int IIN = (DM / 64) * (NINP / 32), IOUT = (DM / 64) * (DM / 32);
            for (int it = gw; it < IIN + IOUT; it += NGW) {
                if (it < IIN) { const int kb = it / (NINP / 32), nb = it % (NINP / 32); transpose_item(p.w_in, DM, NIN, NIN, WIN, nb * 32, kb * 64, nb * 32, scr, lane); }
                else { const int r = it - IIN; const int kb = r / (DM / 32), nb = r % (DM / 32); transpose_item(p.w_out, DM, DM, DM, WOUT, nb * 32, kb * 64, nb * 32, scr, lane); }
            } }
        for (int task = gw; task < 72 * KSL; task += NGW) {
            const int cgp = task % 72, ks = task / 72, col = cgp * 256 + lane * 4, k0 = ks * 64;
            float cv[4];
#pragma unroll
            for (int b = 0; b < 4; ++b) cv[b] = silu_f(p.c[b * DM + k0 + lane]);
            f32x4 a[4];
#pragma unroll
            for (int b = 0; b < 4; ++b) a[b] = (f32x4){0.f, 0.f, 0.f, 0.f};
#pragma unroll 8
            for (int r = 0; r < 64; ++r) {
                const f32x4 w = *(const f32x4*)(p.w_ada + (size_t)(k0 + r) * NMOD + col);
#pragma unroll
                for (int b = 0; b < 4; ++b) { const float s = __builtin_bit_cast(float, __builtin_amdgcn_readlane(__builtin_bit_cast(int, cv[b]), r)); a[b] += s * w; }
            }
#pragma unroll
            for (int b = 0; b < 4; ++b) *(f32x4*)(PART + ((size_t)ks * 4 + b) * NMOD + col) = a[b];
        }
        for (int t = blockIdx.x * 512 + tid; t < NT * 24; t += gridDim.x * 512) {
            const int tok = t / 24, i = t % 24;
            const float inv = i < 16 ? p.invB[i] : p.invI[i - 16];
            const float ang = (float)p.pos[tok] * inv;
            const double a = (double)ang, kq = rint(a * 0.6366197723675814);
            double r = fma(-kq, 1.5707963267948966, a); r = fma(-kq, 6.123233995736766e-17, r);
            const int q = ((int)kq) & 3; const double r2 = r * r;
            const double sn = r * (1.0 + r2 * (-1.0 / 6 + r2 * (1.0 / 120 + r2 * (-1.0 / 5040 + r2 * (1.0 / 362880 + r2 * (-1.0 / 39916800 + r2 * (1.0 / 6227020800.0)))))));
            const double cs = 1.0 + r2 * (-0.5 + r2 * (1.0 / 24 + r2 * (-1.0 / 720 + r2 * (1.0 / 40320 + r2 * (-1.0 / 3628800 + r2 * (1.0 / 479001600.0 - r2 * (1.0 / 87178291200.0)))))));
            const double sq = (q == 0) ? sn : (q == 1) ? cs : (q == 2) ? -sn : -cs;
            const double cq = (q == 0) ? cs : (q == 1) ? -sn : (q == 2) ? -cs : sn;
            if (i < 16) { COSB[tok * 16 + i] = (float)cq; SINB[tok * 16 + i] = (float)sq; } else { COSI[tok * 8 + i - 16] = (float)cq; SINI[tok * 8 + i - 16] = (float)sq; }
        }
    }
    SEAM(0)
    PHASE(1) {
        for (int i = blockIdx.x * 512 + tid; i < NB * NMOD; i += gridDim.x * 512) {
            const int b = i / NMOD, n = i % NMOD; float s = p.b_ada[n];
            for (int k = 0; k < KSL; ++k) s += PART[((size_t)k * 4 + b) * NMOD + n];
            MOD[i] = s;
        }
        float* cA = (float*)shm; float* cB = cA + DM;
        const float* bada = p.b_ada;
        auto modv = [PART, bada](int b, int n) { float s = bada[n]; for (int k = 0; k < KSL; ++k) s += PART[((size_t)k * 4 + b) * NMOD + n]; return s; };
        for (int rbi = blockIdx.x; rbi < NT / 64; rbi += gridDim.x) { const int rb = (rbi & 7) * 32 + (rbi >> 3); norm_rows(p.x, p.n1g, 0, 1, H, cA, cB, modv, rb); }
    }
    SEAM(1)
    PHASE(2) { EpiSwiglu E{ACT}; gemm_phase<4>((LAS unsigned char*)shm, H, W13, NT, 2 * FF, DM, E); }
#if EXTRA_GEMM == 2
    { EpiSwiglu E{ACT}; gemm_phase<4>((LAS unsigned char*)shm, H, W13, NT, 2 * FF, DM, E); }
#endif
#if EXTRA_GEMM == 40
    { EpiNull E{MOD}; gemm_phase<8, EpiNull, false, -1, false>((LAS unsigned char*)shm, H, W13, NT, 2 * FF, DM, E); }
#endif
#if EXTRA_GEMM == 41
    { EpiNull E{MOD}; gemm_phase<8, EpiNull, false, -1, true>((LAS unsigned char*)shm, H, W13, NT, 2 * FF, DM, E); }
#endif
#if EXTRA_GEMM == 22
    { EpiSwiglu E{ACT}; gemm_phase<8, EpiSwiglu, true>((LAS unsigned char*)shm, H, W13, NT, 2 * FF, DM, E); }
#endif
    SEAM(2)
    PHASE(3) { EpiResid<float, h16> E{p.x, X1H, MOD + 2 * DM, 0.5f}; gemm_phase<4>((LAS unsigned char*)shm, ACT, W2, NT, DM, FF, E); }
#if EXTRA_GEMM == 33
    { EpiResid<float, h16> E{p.x, X1H, MOD + 2 * DM, 0.5f}; gemm_phase<4, EpiResid<float, h16>, true>((LAS unsigned char*)shm, ACT, W2, NT, DM, FF, E); }
#endif
#if EXTRA_GEMM == 3
    { EpiResid<float, h16> E{p.x, X1H, MOD + 2 * DM, 0.5f}; gemm_phase<4>((LAS unsigned char*)shm, ACT, W2, NT, DM, FF, E); }
#endif
    SEAM(3)
    PHASE(4) {
        float* cA = (float*)shm; float* cB = cA + DM;
        auto modv = [MOD](int b, int n) { return MOD[(size_t)b * NMOD + n]; };
        for (int rbi = blockIdx.x; rbi < NT / 64; rbi += gridDim.x) { const int rb = (rbi & 7) * 32 + (rbi >> 3); norm_rows(X1H, p.n2g, 3, 4, H, cA, cB, modv, rb); }
    }
    SEAM(4)
    PHASE(5) { EpiProj E{P16, IQH, IKH, IW, COSI, SINI, VTG}; gemm_phase<4, EpiProj, false, 24, false, 16, 20>((LAS unsigned char*)shm, H, WIN, NT, NINP, DM, E);
        const int nextra = (64 * (NINP / 256)) % (int)gridDim.x;
        if ((int)blockIdx.x >= nextra) { float* scr = (float*)shm + wave * (64 * 33);
            convert_ffn(p.f2w1, p.f2w3, p.f2w2, W13, W2, scr, ((int)blockIdx.x - nextra) * 8 + wave, ((int)gridDim.x - nextra) * 8, lane); }
    }
#if EXTRA_GEMM == 5
    { EpiProj E{P16, IQH, IKH, IW, COSI, SINI}; gemm_phase<8>((LAS unsigned char*)shm, H, WIN, NT, NINP, DM, E); }
#endif
    SEAM(5)
    PHASE(6) {
        const int li = lane & 15;
        h16x8 nvin[4];
        if (gw < NT) {
#pragma unroll
            for (int ch = 4; ch < 8; ++ch) nvin[ch - 4] = *(const h16x8*)(P16 + (size_t)gw * 5120 + ch * 512 + lane * 8); }
        for (int row = gw; row < NT; row += NGW) {
            h16* pr = P16 + (size_t)row * 5120;
            const float* cb = COSB + (size_t)row * 16; const float* sb = SINB + (size_t)row * 16;
            h16x8 vin[8];
#pragma unroll
            for (int ch = 4; ch < 8; ++ch) vin[ch] = nvin[ch - 4];
            if (row + NGW < NT) {
#pragma unroll
                for (int ch = 4; ch < 8; ++ch) nvin[ch - 4] = *(const h16x8*)(P16 + (size_t)(row + NGW) * 5120 + ch * 512 + lane * 8); }
#pragma unroll
            for (int ch = 4; ch < 8; ++ch) {
                h16x8 v = vin[ch];
                float f[8];
#pragma unroll
                for (int e = 0; e < 8; ++e) f[e] = (float)v[e];
                if (ch < 2) {
#pragma unroll
                    for (int e = 0; e < 8; ++e) f[e] = gelu_t(f[e]);
                } else if (ch < 4) {
                    float s = 0.f;
#pragma unroll
                    for (int e = 0; e < 8; ++e) { f[e] = gelu_t(f[e]); s += f[e]; }
                    const float mu = red16(s) * (1.f / 128.f); float ss = 0.f;
#pragma unroll
                    for (int e = 0; e < 8; ++e) { f[e] -= mu; ss += f[e] * f[e]; }
                    const float rstd = rsqrtf(red16(ss) * (1.f / 128.f) + EPS);
                    const float* g = p.vg + (ch - 2) * 512 + lane * 8;
#pragma unroll
                    for (int e = 0; e < 8; ++e) f[e] = f[e] * rstd * g[e];
                } else {
                    float ss = 0.f;
#pragma unroll
                    for (int e = 0; e < 8; ++e) ss += f[e] * f[e];
                    const float rstd = rsqrtf(red16(ss) * (1.f / 128.f) + EPS);
                    const float* g = (ch < 6 ? p.qg : p.kg) + li * 8;
                    float py[8];
#pragma unroll
                    for (int e = 0; e < 8; ++e) { f[e] = f[e] * rstd * g[e]; py[e] = __shfl_xor(f[e], 2); }
                    if (li < 4) {
#pragma unroll
                        for (int e = 0; e < 8; ++e) { const int fi = (li & 1) * 8 + e; const float cs = cb[fi], sn = sb[fi];
                            f[e] = (li < 2) ? f[e] * cs - py[e] * sn : f[e] * cs + py[e] * sn; }
                    }
                    if (ch < 6) {
#pragma unroll
                        for (int e = 0; e < 8; ++e) f[e] *= 0.12751743f;
                    }
                }
#pragma unroll
                for (int e = 0; e < 8; ++e) v[e] = (h16)f[e];
                *(h16x8*)(pr + ch * 512 + lane * 8) = v;
            }
        }
    }
    PHASE(7) {
        {
            h16* VT = (h16*)shm;
            const int fr = lane & 15, fq = lane >> 4;
            h16x8 nvn[4];
#define GM_LOAD(u_) do { const int g_ = (u_) & 7, win_ = ((u_) >> 3) & 31, b_ = (u_) >> 8; _Pragma("unroll") for (int i = 0; i < 4; ++i) { const int pc = tid + 512 * i; \
                nvn[i] = *(const h16x8*)(P16 + ((size_t)b_ * SEQ + win_ * 128 + (pc >> 4)) * 5120 + 1024 + g_ * 128 + (pc & 15) * 8); } } while (0)
            if ((int)blockIdx.x < NB * 32 * 8) GM_LOAD((int)blockIdx.x);
            for (int u = blockIdx.x; u < NB * 32 * 8; u += gridDim.x) {
                const int g = u & 7, win = (u >> 3) & 31, b = u >> 8;
                const size_t tok0 = (size_t)b * SEQ + win * 128;
                const int irow = 16 * wave + fr;
                const size_t tok = tok0 + irow;
                h16x8 cvn[4];
#pragma unroll
                for (int i = 0; i < 4; ++i) cvn[i] = nvn[i];
                f32x4 w0[4], w1[4]; h16x4 uu[8];
#pragma unroll
                for (int ks = 0; ks < 4; ++ks) { const float* wp = p.gws + ((size_t)g * 128 + irow) * 128 + 32 * ks + 8 * fq; w0[ks] = *(const f32x4*)wp; w1[ks] = *(const f32x4*)(wp + 4); }
#pragma unroll
                for (int nt = 0; nt < 8; ++nt) uu[nt] = *(const h16x4*)(P16 + tok * 5120 + g * 128 + 16 * nt + 4 * fq);
                const float bias = p.gb[g * 128 + irow];
                if (u + (int)gridDim.x < NB * 32 * 8) GM_LOAD(u + (int)gridDim.x);
                __syncthreads();
#pragma unroll
                for (int i = 0; i < 4; ++i) { const int pc = tid + 512 * i, j = pc >> 4, c8 = pc & 15;
                    float f[8]; float s1 = 0.f;
#pragma unroll
                    for (int e = 0; e < 8; ++e) { f[e] = gelu_t((float)cvn[i][e]); s1 += f[e]; }
                    const float mu = red16(s1) * (1.f / 128.f); float s2 = 0.f;
#pragma unroll
                    for (int e = 0; e < 8; ++e) { f[e] -= mu; s2 += f[e] * f[e]; }
                    const float rs = rsqrtf(red16(s2) * (1.f / 128.f) + EPS);
                    const float* gp = p.vg + g * 128 + c8 * 8;
#pragma unroll
                    for (int e = 0; e < 8; ++e) VT[(c8 * 8 + e) * 136 + ((((j >> 3) ^ c8) & 15) << 3) + (j & 7)] = (h16)(f[e] * rs * gp[e]); }
                __syncthreads();
                h16x8 wf[4];
#pragma unroll
                for (int ks = 0; ks < 4; ++ks) { const int j0 = 32 * ks + 8 * fq; const bool ok = (j0 >> 6) <= (irow >> 6);
#pragma unroll
                    for (int e = 0; e < 4; ++e) { wf[ks][e] = ok ? (h16)w0[ks][e] : (h16)0.f; wf[ks][4 + e] = ok ? (h16)w1[ks][e] : (h16)0.f; } }
                f32x4 acc[8];
#pragma unroll
                for (int nt = 0; nt < 8; ++nt) { acc[nt] = (f32x4){0.f, 0.f, 0.f, 0.f};
#pragma unroll
                    for (int ks = 0; ks < 4; ++ks) { const h16x8 vf = *(const h16x8*)(VT + (16 * nt + fr) * 136 + ((((4 * ks + fq) ^ ((16 * nt + fr) >> 3)) & 15) << 3));
                        acc[nt] = __builtin_amdgcn_mfma_f32_16x16x32_f16(vf, wf[ks], acc[nt], 0, 0, 0); } }
                float ss = 0.f;
#pragma unroll
                for (int nt = 0; nt < 8; ++nt) {
#pragma unroll
                    for (int e = 0; e < 4; ++e) { const float o = (float)uu[nt][e] * (acc[nt][e] + bias); acc[nt][e] = o; ss += o * o; } }
                ss += __shfl_xor(ss, 16); ss += __shfl_xor(ss, 32);
                const float rstd = rsqrtf(ss * (1.f / 128.f) + EPS);
#pragma unroll
                for (int nt = 0; nt < 8; ++nt) { const f32x4 gg = *(const f32x4*)(p.ong + g * 128 + 16 * nt + 4 * fq); h16x4 o;
#pragma unroll
                    for (int e = 0; e < 4; ++e) o[e] = (h16)(acc[nt][e] * rstd * gg[e]);
                    *(h16x4*)(H + tok * DM + g * 128 + 16 * nt + 4 * fq) = o; }
            }
            __syncthreads();
        }
        {
            h16* IQS = (h16*)shm;
            float* WS = (float*)(shm + 32 * 1032 * 2);
            const int fr = lane & 15, fq = lane >> 4;
            for (int pi = blockIdx.x; pi < 256; pi += gridDim.x) {
                const int b = pi >> 6, r = pi & 63;
#pragma unroll 1
                for (int half = 0; half < 2; ++half) {
                    const int c32 = half ? 127 - r : r, chunk = c32 >> 1, nkt = chunk + 1, N = 64 * nkt;
                    const size_t tok0 = (size_t)b * SEQ + c32 * 32;
                    __syncthreads();
#pragma unroll
                    for (int i = 0; i < 8; ++i) { const int pc = tid + 512 * i, q = pc >> 7, c8 = pc & 127;
                        *(h16x8*)(IQS + q * 1032 + c8 * 8) = *(const h16x8*)(IQH + (tok0 + q) * 1024 + c8 * 8); }
                    WS[tid] = IW[tok0 * 16 + tid];
                    __syncthreads();
                    float* scb = SC + (size_t)b * SC_PER_B + (size_t)4096 * (chunk * (chunk + 1) / 2) + (size_t)((c32 & 1) * 32) * N;
                    h16x8 kfn[4][2];
#define IK_LOAD(kt_) do { _Pragma("unroll") for (int kk = 0; kk < 4; ++kk) _Pragma("unroll") for (int ks = 0; ks < 2; ++ks) \
                        kfn[kk][ks] = *(const h16x8*)(IKH + ((size_t)b * SEQ + 64 * (kt_) + 16 * kk + fr) * 64 + 32 * ks + 8 * fq); } while (0)
                    if (wave < nkt) IK_LOAD(wave);
                    for (int kt = wave; kt < nkt; kt += 8) {
                        h16x8 kf[4][2];
#pragma unroll
                        for (int kk = 0; kk < 4; ++kk)
#pragma unroll
                            for (int ks = 0; ks < 2; ++ks) kf[kk][ks] = kfn[kk][ks];
                        if (kt + 8 < nkt) IK_LOAD(kt + 8);
                        f32x4 s[2][4];
#pragma unroll
                        for (int qt = 0; qt < 2; ++qt)
#pragma unroll
                            for (int kk = 0; kk < 4; ++kk) s[qt][kk] = (f32x4){0.f, 0.f, 0.f, 0.f};
#pragma unroll 4
                        for (int h = 0; h < 16; ++h) {
#pragma unroll
                            for (int qt = 0; qt < 2; ++qt) {
                                const h16x8 q0 = *(const h16x8*)(IQS + (16 * qt + fr) * 1032 + h * 64 + 8 * fq);
                                const h16x8 q1 = *(const h16x8*)(IQS + (16 * qt + fr) * 1032 + h * 64 + 32 + 8 * fq);
                                const float wv = WS[(16 * qt + fr) * 16 + h];
#pragma unroll
                                for (int kk = 0; kk < 4; ++kk) {
                                    f32x4 t = (f32x4){0.f, 0.f, 0.f, 0.f};
                                    t = __builtin_amdgcn_mfma_f32_16x16x32_f16(kf[kk][0], q0, t, 0, 0, 0);
                                    t = __builtin_amdgcn_mfma_f32_16x16x32_f16(kf[kk][1], q1, t, 0, 0, 0);
#pragma unroll
                                    for (int e = 0; e < 4; ++e) s[qt][kk][e] += wv * fmaxf(t[e], 0.f);
                                }
                            }
                        }
#pragma unroll
                        for (int qt = 0; qt < 2; ++qt)
#pragma unroll
                            for (int kk = 0; kk < 4; ++kk) *(f32x4*)(scb + (size_t)(16 * qt + fr) * N + 64 * kt + 16 * kk + 4 * fq) = s[qt][kk];
                    }
                }
            }
            __syncthreads();
        }
    }
    SEAM(7)
    PHASE(8) {
        unsigned* hist = (unsigned*)(shm + wave * 9216);
        unsigned* cand = (unsigned*)(shm + wave * 9216 + 8192);
        unsigned raw[64];
#define P8_LOAD(idx_) do { const int b_ = (idx_) >> 12, j_ = (idx_) & 4095, q_ = j_ < 2048 ? j_ : 6143 - j_, ch_ = q_ >> 6, nm_ = ch_ + 1; \
            const float* sp_ = SC + (size_t)b_ * SC_PER_B + (size_t)4096 * (ch_ * (ch_ + 1) / 2) + (size_t)(q_ & 63) * (64 * nm_) + lane; \
            _Pragma("unroll") for (int m = 0; m < 64; ++m) raw[m] = (m < nm_) ? __builtin_bit_cast(unsigned, sp_[64 * m]) : 0xFFFFFFFFu; } while (0)
        if (gw < NT) P8_LOAD(gw);
        for (int idx = gw; idx < NT; idx += NGW) {
            const int b = idx >> 12, jj = idx & 4095, q = jj < 2048 ? jj : 6143 - jj, row = b * 4096 + q;
            const int chunk = q >> 6, nm = chunk + 1;
            unsigned u[64];
#pragma unroll
            for (int m = 0; m < 64; ++m) { const unsigned bits = raw[m]; u[m] = (bits & 0x80000000u) ? ~bits : (bits | 0x80000000u); }
            if (idx + NGW < NT) P8_LOAD(idx + NGW);
            unsigned T = 0u;
            if (nm > 4) {
#pragma unroll
                for (int i = 0; i < 8; ++i) ((uint4*)hist)[lane + 64 * i] = make_uint4(0u, 0u, 0u, 0u);
                WAVE_LDS_SYNC();
                unsigned bpk[32];
#pragma unroll
                for (int m8 = 0; m8 < 8; ++m8) {
                    if (m8 * 8 < nm) {
#pragma unroll
                        for (int e = 0; e < 8; e += 2) { const int b0 = binof(u[m8 * 8 + e]), b1 = binof(u[m8 * 8 + e + 1]);
                            atomicAdd(&hist[b0], 1u); atomicAdd(&hist[b1], 1u); bpk[m8 * 4 + (e >> 1)] = (unsigned)b0 | ((unsigned)b1 << 16); }
                    } else {
#pragma unroll
                        for (int e = 0; e < 4; ++e) bpk[m8 * 4 + e] = 0u;
                    }
                }
                WAVE_LDS_SYNC();
                uint4 hv[8]; unsigned tl = 0u;
#pragma unroll
                for (int i = 0; i < 8; ++i) { hv[i] = ((const uint4*)hist)[lane * 8 + i]; tl += (hv[i].x + hv[i].y) + (hv[i].z + hv[i].w); }
                unsigned S = tl;
#pragma unroll
                for (int o = 1; o < 64; o <<= 1) { const unsigned t = __shfl_down(S, o); if (lane + o < 64) S += t; }
                const unsigned above = S - tl;
                const bool owner = (above < 256u) && (S >= 256u);
                unsigned c = above, Bv = 0u, cv = 0u; bool found = false;
#pragma unroll
                for (int i = 7; i >= 0; --i) {
                    const unsigned hh[4] = {hv[i].x, hv[i].y, hv[i].z, hv[i].w};
#pragma unroll
                    for (int e = 3; e >= 0; --e) { if (!found && c + hh[e] >= 256u) { found = true; Bv = 32u * lane + 4u * i + e; cv = c; } c += hh[e]; }
                }
                const unsigned long long om = __ballot(owner);
                const int ol = om ? __ffsll((long long)om) - 1 : 0;
                const int B = __builtin_amdgcn_readlane((int)Bv, ol), chi = __builtin_amdgcn_readlane((int)cv, ol);
                const int r = 256 - chi;
                int M = 0;
#pragma unroll
                for (int m8 = 0; m8 < 8; ++m8) if (m8 * 8 < nm) {
#pragma unroll
                    for (int e = 0; e < 8; ++e) { const unsigned pk = bpk[m8 * 4 + (e >> 1)]; const int bin = (e & 1) ? (int)(pk >> 16) : (int)(pk & 0xFFFFu);
                        const bool pred = bin == B; const unsigned long long bm = __ballot(pred);
                        if (bm) {
                            const unsigned key = u[m8 * 8 + e];
                            if (pred) { const int pos = M + (int)__builtin_amdgcn_mbcnt_hi((unsigned)(bm >> 32), __builtin_amdgcn_mbcnt_lo((unsigned)bm, 0u)); if (pos < 256) cand[pos] = key; }
                            M += __popcll(bm); } }
                }
                WAVE_LDS_SYNC();
                bool done = false;
                if (M <= 256 && om != 0ull) {
                    for (int c0 = 0; c0 < M; c0 += 64) {
                        const bool act = c0 + lane < M; const unsigned x = act ? cand[c0 + lane] : 0u; int gt = 0, ge = 0;
                        for (int i = 0; i < M; ++i) { const unsigned y = cand[i]; gt += (y > x) ? 1 : 0; ge += (y >= x) ? 1 : 0; }
                        const unsigned long long hm = __ballot(act && gt < r && r <= ge);
                        if (hm) { T = (unsigned)__builtin_amdgcn_readlane((int)x, __ffsll((long long)hm) - 1); done = true; }
                    }
                }
                if (!done) {
                    T = 0u;
                    for (int bit = 31; bit >= 0; --bit) {
                        const unsigned Tc = T | (1u << bit); int cnt = 0;
#pragma unroll
                        for (int m8 = 0; m8 < 8; ++m8) if (m8 * 8 < nm) {
#pragma unroll
                            for (int e = 0; e < 8; ++e) cnt += __popcll(__ballot(u[m8 * 8 + e] >= Tc));
                        }
                        if (cnt >= 256) T = Tc;
                    }
                }
                WAVE_LDS_SYNC();
            }
            if (T == 0u) T = 1u;
            unsigned long long w = 0ull;
#pragma unroll
            for (int m = 0; m < 64; ++m) { const unsigned long long bal = __ballot(u[m] >= T); w = (lane == m) ? bal : w; if ((m & 7) == 7) __builtin_amdgcn_sched_barrier(0); }
            MASK[(size_t)row * 64 + lane] = w;
        }
    }
    SEAM(8)
    PHASE(9) {
        h16* KS = (h16*)shm;
        h16* VT = (h16*)(shm + 2 * 64 * 136 * 2);
        const int ql = lane & 31, hf = lane >> 5;
        for (int pi = blockIdx.x; pi < 256; pi += gridDim.x) {
            const int xq = pi & 7, iq = pi >> 3, rr = iq & 7;
            const int b = xq >> 1, h = 4 * (xq & 1) + (iq >> 3);
#pragma unroll 1
            for (int side = 0; side < 2; ++side) {
                const int qb = side ? 15 - rr : rr, nkt = 4 * qb + 4, cw = 4 * qb + (wave >> 1);
                const size_t tokq = (size_t)b * SEQ + qb * 256 + wave * 32 + ql;
                h16x8 qf[8];
#pragma unroll
                for (int ks = 0; ks < 8; ++ks) qf[ks] = *(const h16x8*)(P16 + tokq * 5120 + 2048 + h * 128 + 16 * ks + 8 * hf);
                f32x16 O[4];
#pragma unroll
                for (int dt = 0; dt < 4; ++dt)
#pragma unroll
                    for (int i = 0; i < 16; ++i) O[dt][i] = 0.f;
                float mrow = -1e30f, lrow = 0.f;
                unsigned long long mwn = MASK[tokq * 64];
                h16x8 kreg[2], vreg[2];
                const size_t kvbase = (size_t)b * SEQ * 5120 + h * 128;
                const h16* vtbase = VTG + ((size_t)b * 8 + h) * 128 * SEQ;
#pragma unroll
                for (int i = 0; i < 2; ++i) { const int pc = tid + 512 * i;
                    kreg[i] = *(const h16x8*)(P16 + kvbase + (size_t)(pc >> 4) * 5120 + 3072 + (pc & 15) * 8);
                    vreg[i] = *(const h16x8*)(vtbase + (size_t)(pc >> 3) * SEQ + (pc & 7) * 8); }
                __syncthreads();
#pragma unroll
                for (int i = 0; i < 2; ++i) { const int pc = tid + 512 * i;
                    *(h16x8*)(KS + (pc >> 4) * 136 + (pc & 15) * 8) = kreg[i];
                    *(h16x8*)(VT + (pc >> 3) * 72 + (pc & 7) * 8) = vreg[i]; }
                __syncthreads();
                for (int kt = 0; kt < nkt; ++kt) {
                    const int cur = kt & 1;
                    const unsigned long long mw = mwn;
                    if (kt + 1 < nkt) mwn = MASK[tokq * 64 + kt + 1];
                    if (kt + 1 < nkt) {
#pragma unroll
                        for (int i = 0; i < 2; ++i) { const int pc = tid + 512 * i; const size_t kb = kvbase + (size_t)(64 * (kt + 1)) * 5120;
                            kreg[i] = *(const h16x8*)(P16 + kb + (size_t)(pc >> 4) * 5120 + 3072 + (pc & 15) * 8);
                            vreg[i] = *(const h16x8*)(vtbase + (size_t)(pc >> 3) * SEQ + 64 * (kt + 1) + (pc & 7) * 8); }
                    }
                    if (kt <= cw) {
                        const h16* ksb = KS + cur * (64 * 136); const h16* vtb = VT + cur * (128 * 72);
                        const unsigned msk[2] = {~((unsigned)mw >> (4 * hf)), ~((unsigned)(mw >> 32) >> (4 * hf))};
                        f32x16 s[2];
#pragma unroll
                        for (int sub = 0; sub < 2; ++sub) {
#pragma unroll
                            for (int i = 0; i < 16; ++i) {
                                const int t = __builtin_amdgcn_sbfe((int)msk[sub], 8 * (i >> 2) + (i & 3), 1);
                                s[sub][i] = __builtin_bit_cast(float, t & (int)0xf149f2ca); }
#pragma unroll
                            for (int ks = 0; ks < 8; ++ks) { const h16x8 kfr = *(const h16x8*)(ksb + (32 * sub + ql) * 136 + 16 * ks + 8 * hf);
                                s[sub] = __builtin_amdgcn_mfma_f32_32x32x16_f16(kfr, qf[ks], s[sub], 0, 0, 0); }
                        }
                        float mx = -1e30f;
#pragma unroll
                        for (int sub = 0; sub < 2; ++sub)
#pragma unroll
                            for (int i = 0; i < 16; ++i) mx = fmaxf(mx, s[sub][i]);
                        mx = fmaxf(mx, __shfl_xor(mx, 32));
                        if (__any(mx - mrow > 11.5f)) {
                            const float mnew2 = fmaxf(mrow, mx);
                            const float alpha = __builtin_amdgcn_exp2f(mrow - mnew2);
                            lrow *= alpha;
#pragma unroll
                            for (int dt = 0; dt < 4; ++dt)
#pragma unroll
                                for (int i = 0; i < 16; ++i) O[dt][i] *= alpha;
                            mrow = mnew2;
                        }
                        const float mnew = mrow;
#pragma unroll
                        for (int sub = 0; sub < 2; ++sub) {
                            h16x8 pf[2];
#pragma unroll
                            for (int i = 0; i < 16; ++i) { const float pv = __builtin_amdgcn_exp2f(s[sub][i] - mnew); lrow += pv; pf[i >> 3][i & 7] = (h16)pv; }
#pragma unroll
                            for (int j = 0; j < 2; ++j)
#pragma unroll
                                for (int dt = 0; dt < 4; ++dt) { const h16x8 vfr = *(const h16x8*)(vtb + (32 * dt + ql) * 72 + 32 * sub + 16 * j + 8 * hf);
                                    O[dt] = __builtin_amdgcn_mfma_f32_32x32x16_f16(vfr, pf[j], O[dt], 0, 0, 0); }
                        }
                    }
                    if (kt + 1 < nkt) {
                        h16* ksn = KS + (cur ^ 1) * (64 * 136); h16* vtn = VT + (cur ^ 1) * (128 * 72);
#pragma unroll
                        for (int i = 0; i < 2; ++i) { const int pc = tid + 512 * i;
                            *(h16x8*)(ksn + (pc >> 4) * 136 + (pc & 15) * 8) = kreg[i];
                            *(h16x8*)(vtn + (pc >> 3) * 72 + (pc & 7) * 8) = vreg[i]; }
                    }
                    __syncthreads();
                }
                float lt = lrow + __shfl_xor(lrow, 32);
                const float il = 1.f / lt; float ss = 0.f;
#pragma unroll
                for (int dt = 0; dt < 4; ++dt)
#pragma unroll
                    for (int i = 0; i < 16; ++i) { O[dt][i] *= il; ss += O[dt][i] * O[dt][i]; }
                ss += __shfl_xor(ss, 32);
                const float rstd = rsqrtf(ss * (1.f / 128.f) + EPS);
#pragma unroll
                for (int dt = 0; dt < 4; ++dt)
#pragma unroll
                    for (int i4 = 0; i4 < 4; ++i4) { const int d0 = 32 * dt + 8 * i4 + 4 * hf; const f32x4 gg = *(const f32x4*)(p.ong + 1024 + h * 128 + d0); h16x4 o;
#pragma unroll
                        for (int e = 0; e < 4; ++e) o[e] = (h16)(O[dt][4 * i4 + e] * rstd * gg[e]);
                        *(h16x4*)(H + tokq * DM + 1024 + h * 128 + d0) = o; }
            }
        }
        __syncthreads();
    }
    SEAM(9)
    PHASE(10) { EpiResid<h16, h16> E{X1H, X2H, MOD + 5 * DM, 1.0f}; gemm_phase<4>((LAS unsigned char*)shm, H, WOUT, NT, DM, DM, E); }
    SEAM(10)
    PHASE(11) {
        float* cA = (float*)shm; float* cB = cA + DM;
        auto modv = [MOD](int b, int n) { return MOD[(size_t)b * NMOD + n]; };
        for (int rbi = blockIdx.x; rbi < NT / 64; rbi += gridDim.x) { const int rb = (rbi & 7) * 32 + (rbi >> 3); norm_rows(X2H, p.n3g, 6, 7, H, cA, cB, modv, rb); }
    }
    SEAM(11)
    PHASE(12) { EpiSwiglu E{ACT}; gemm_phase<4>((LAS unsigned char*)shm, H, W13, NT, 2 * FF, DM, E); }
    SEAM(12)
    PHASE(13) { EpiResid<h16, float> E{X2H, p.out, MOD + 8 * DM, 0.5f}; gemm_phase<4>((LAS unsigned char*)shm, ACT, W2, NT, DM, FF, E); }
}

extern "C" void kernel_launch(void* const* d_in, const int* in_sizes, int n_in, void* d_out, int out_size, void* d_ws, size_t ws_size, hipStream_t stream) {
    static int grid = 0;
    if (grid == 0) {
        if (n_in != 22 || ws_size < WS_END) { fprintf(stderr, "kernel_launch: need 22 inputs and %zu bytes of workspace (got %d, %zu)\n", (size_t)WS_END, n_in, ws_size); grid = -1; return; }
        int dev = 0, cus = 0, per_cu = 0;
        hipGetDevice(&dev); hipDeviceGetAttribute(&cus, hipDeviceAttributeMultiprocessorCount, dev);
        hipFuncSetAttribute((const void*)mk_fwd, hipFuncAttributeMaxDynamicSharedMemorySize, LDS_BYTES);
        if (hipOccupancyMaxActiveBlocksPerMultiprocessor(&per_cu, (const void*)mk_fwd, 512, LDS_BYTES) != hipSuccess || per_cu < 1) { fprintf(stderr, "kernel_launch: occupancy query says %d\n", per_cu); per_cu = 1; }
        (void)hipGetLastError();
        grid = cus * (per_cu > 1 ? 1 : per_cu);
        if (grid <= 0) grid = 256;
    }
    if (grid < 0) return;
    Params p{};
    const float** fp = (const float**)&p.x;
    (void)fp;
    p.x = (const float*)d_in[0]; p.c = (const float*)d_in[1]; p.pos = (const int*)d_in[2];
    p.w_ada = (const float*)d_in[3]; p.b_ada = (const float*)d_in[4]; p.n1g = (const float*)d_in[5];
    p.f1w1 = (const float*)d_in[6]; p.f1w3 = (const float*)d_in[7]; p.f1w2 = (const float*)d_in[8];
    p.n2g = (const float*)d_in[9]; p.w_in = (const float*)d_in[10]; p.vg = (const float*)d_in[11];
    p.gws = (const float*)d_in[12]; p.gb = (const float*)d_in[13]; p.qg = (const float*)d_in[14]; p.kg = (const float*)d_in[15];
    p.ong = (const float*)d_in[16]; p.w_out = (const float*)d_in[17]; p.n3g = (const float*)d_in[18];
    p.f2w1 = (const float*)d_in[19]; p.f2w3 = (const float*)d_in[20]; p.f2w2 = (const float*)d_in[21];
    p.out = (float*)d_out; p.ws = (unsigned char*)d_ws;
    for (int i = 0; i < 16; ++i) p.invB[i] = (float)std::pow(500000.0, -2.0 * i / 32.0);
    for (int i = 0; i < 8; ++i) p.invI[i] = (float)std::pow(500000.0, -2.0 * i / 16.0);
#if MK_SINGLE
    if (hipMemsetAsync((char*)d_ws + OFF_BAR, 0, (size_t)XCD_BAR_WORDS_C * 4, stream) != hipSuccess) { fprintf(stderr, "kernel_launch: memset of barrier words failed\n"); return; }
    p.ph_lo = 0; p.ph_hi = NPH;
    void* args[] = {&p};
    hipError_t e = hipLaunchCooperativeKernel((const void*)mk_fwd, dim3(grid), dim3(512), args, LDS_BYTES, stream);
    if (e != hipSuccess) fprintf(stderr, "cooperative launch failed: %s (grid %d)\n", hipGetErrorString(e), grid);
#else
    for (int k = 0; k < NPH; ++k) { p.ph_lo = k; p.ph_hi = k + 1; hipLaunchKernelGGL(mk_fwd, dim3(grid), dim3(512), LDS_BYTES, stream, p); }
#endif
}
```
